# Optimizing an MI355X kernel written in HIP

```python
import jax, jax.numpy as jnp
from jax import lax
import numpy as np

D_MODEL = 1024
BATCH = 16
SEQ = 4096
DEPTH = 4

MIX_WIDTH = D_MODEL // 4
HEAD_DIM = 64
N_BRANCH = 4

A_WIDTH = MIX_WIDTH
A_GROUPS = A_WIDTH // HEAD_DIM
A_GROUP_DIM = A_WIDTH // A_GROUPS
A_CHUNK = 128

B_HEADS = MIX_WIDTH // HEAD_DIM
B_HEAD_DIM = HEAD_DIM
B_ROT_DIM = B_HEAD_DIM // 4
MOBA_BLOCK = 256
MOBA_TOPK = 3
MOBA_QBLK = 32

C_WIDTH = MIX_WIDTH
CONV_WIDTH = 3

D_HEADS = MIX_WIDTH // HEAD_DIM
D_NOPE = 64
D_ROPE = 32
D_V = 64
D_Q_LORA = 192
D_KV_LORA = 128
MLA_QBLK = 128

D_FF = 4 * D_MODEL
ROPE_THETA = 500000.0
NORM_EPS = 1e-6

SPLIT_SIZES = (A_WIDTH, A_WIDTH,
               B_HEADS * B_HEAD_DIM, B_HEADS * B_HEAD_DIM, B_HEADS * B_HEAD_DIM,
               C_WIDTH, C_WIDTH, C_WIDTH,
               D_Q_LORA, D_KV_LORA, D_ROPE,
               N_BRANCH * D_MODEL)
IN_COLS = (2 * A_WIDTH + 3 * B_HEADS * B_HEAD_DIM + 3 * C_WIDTH
           + D_Q_LORA + D_KV_LORA + D_ROPE + N_BRANCH * D_MODEL)

kernel_name = 'hybrid_gated_parallel_sgu_moba_shortconv_mla'

F32 = jnp.float32


def rms_norm(x, g):
    xf = x.astype(F32)
    y = xf * lax.rsqrt(jnp.mean(xf * xf, axis=-1, keepdims=True) + NORM_EPS)
    return (y * g.astype(F32)).astype(x.dtype)


def layer_norm(x, g, b):
    xf = x.astype(F32)
    mu = jnp.mean(xf, axis=-1, keepdims=True)
    xc = xf - mu
    var = jnp.mean(xc * xc, axis=-1, keepdims=True)
    return (xc * lax.rsqrt(var + 1e-5) * g.astype(F32) + b.astype(F32)).astype(x.dtype)


def rope_tables(dim, seq):
    inv = 1.0 / (ROPE_THETA ** (jnp.arange(0, dim, 2, dtype=F32) / dim))
    ang = jnp.arange(seq, dtype=F32)[:, None] * inv[None, :]
    return jnp.cos(ang), jnp.sin(ang)


def apply_rope(x, cos, sin):
    half = x.shape[-1] // 2
    x1 = x[..., :half].astype(F32)
    x2 = x[..., half:].astype(F32)
    c = cos[:, None, :]
    s = sin[:, None, :]
    return jnp.concatenate([x1 * c - x2 * s, x2 * c + x1 * s], axis=-1).astype(x.dtype)


def partial_rope(x, cos, sin):
    return jnp.concatenate([apply_rope(x[..., :B_ROT_DIM], cos, sin), x[..., B_ROT_DIM:]], axis=-1)


def split_columns(proj):
    parts = []
    start = 0
    for n in SPLIT_SIZES:
        parts.append(proj[..., start:start + n])
        start += n
    return parts


def chunked_sgu(u, v, ln_g, ln_b, w_s, b_s):
    bsz, s_len, _ = v.shape
    v = layer_norm(v, ln_g, ln_b)
    vc = v.reshape(bsz, s_len // A_CHUNK, A_CHUNK, A_GROUPS, A_GROUP_DIM)
    causal = jnp.arange(A_CHUNK)[:, None] >= jnp.arange(A_CHUNK)[None, :]
    w = jnp.where(causal[None], w_s, jnp.zeros((), w_s.dtype))
    sv = jnp.einsum('gts,bcsgd->bctgd', w, vc) + b_s.T[None, None, :, :, None]
    return u * sv.reshape(bsz, s_len, A_WIDTH)


def moba_attention(q, k, v):
    bsz, s_len, n_h, dh = q.shape
    s_pad = -(-s_len // MOBA_BLOCK) * MOBA_BLOCK
    pad = ((0, 0), (0, s_pad - s_len), (0, 0), (0, 0))
    qh = q.transpose(0, 2, 1, 3)
    kh = jnp.pad(k, pad).transpose(0, 2, 1, 3)
    vh = jnp.pad(v, pad).transpose(0, 2, 1, 3)
    nb = s_pad // MOBA_BLOCK
    n_cand = max(nb, MOBA_TOPK)
    kblk = kh.reshape(bsz, n_h, nb, MOBA_BLOCK, dh)
    vblk = vh.reshape(bsz, n_h, nb, MOBA_BLOCK, dh)
    kmean = jnp.mean(kblk.astype(F32), axis=3)
    scale = dh ** -0.5
    gather = jax.vmap(jax.vmap(lambda blocks, idx: blocks[idx]))
    kl = MOBA_TOPK * MOBA_BLOCK

    def step(i):
        q0 = i * MOBA_QBLK
        qb = lax.dynamic_slice_in_dim(qh, q0, MOBA_QBLK, axis=2)
        cur = q0 // MOBA_BLOCK
        gate = jnp.einsum('bhqd,bhnd->bhqn', qb.astype(F32), kmean)
        if n_cand > nb:
            gate = jnp.pad(gate, ((0, 0), (0, 0), (0, 0), (0, n_cand - nb)))
        gate = jnp.where(jnp.arange(n_cand) < cur, gate, -jnp.inf)
        _, idx = lax.top_k(gate, MOBA_TOPK)
        idx = jnp.minimum(idx, nb - 1)
        valid = jnp.arange(MOBA_TOPK) < cur
        ksel = gather(kblk, idx)
        vsel = gather(vblk, idx)
        s_sel = jnp.einsum('bhqd,bhqkld->bhqkl', qb, ksel, preferred_element_type=F32) * scale
        s_sel = jnp.where(valid[:, None], s_sel, -jnp.inf).reshape(bsz, n_h, MOBA_QBLK, kl)
        kown = lax.dynamic_slice_in_dim(kh, cur * MOBA_BLOCK, MOBA_BLOCK, axis=2)
        vown = lax.dynamic_slice_in_dim(vh, cur * MOBA_BLOCK, MOBA_BLOCK, axis=2)
        s_own = jnp.einsum('bhqd,bhld->bhql', qb, kown, preferred_element_type=F32) * scale
        qpos = q0 + jnp.arange(MOBA_QBLK)
        kpos = cur * MOBA_BLOCK + jnp.arange(MOBA_BLOCK)
        s_own = jnp.where(kpos[None, :] <= qpos[:, None], s_own, -jnp.inf)
        p = jax.nn.softmax(jnp.concatenate([s_sel, s_own], axis=-1), axis=-1)
        p_sel = p[..., :kl].reshape(bsz, n_h, MOBA_QBLK, MOBA_TOPK, MOBA_BLOCK).astype(v.dtype)
        p_own = p[..., kl:].astype(v.dtype)
        return (jnp.einsum('bhqkl,bhqkld->bhqd', p_sel, vsel)
                + jnp.einsum('bhql,bhld->bhqd', p_own, vown))

    outs = lax.map(step, jnp.arange(s_len // MOBA_QBLK))
    return outs.transpose(1, 0, 3, 2, 4).reshape(bsz, s_len, n_h * dh)


def short_conv_mixer(bg, cg, xin, w_conv):
    z = cg * xin
    z = lax.conv_general_dilated(z, w_conv[:, None, :], window_strides=(1,),
                                 padding=[(CONV_WIDTH - 1, 0)],
                                 dimension_numbers=('NWC', 'WIO', 'NWC'),
                                 feature_group_count=C_WIDTH)
    return bg * z


def mla_attention(cq, ckv, kr, q_norm_g, w_uq, kv_norm_g, w_ukv, cos, sin):
    bsz, s_len, _ = cq.shape
    q = jnp.einsum('bsr,rhe->bshe', rms_norm(cq, q_norm_g), w_uq)
    q_nope = q[..., :D_NOPE]
    q_rope = apply_rope(q[..., D_NOPE:], cos, sin)
    kv = jnp.einsum('bsr,rhe->bshe', rms_norm(ckv, kv_norm_g), w_ukv)
    k_nope = kv[..., :D_NOPE]
    v = kv[..., D_NOPE:]
    k_rope = apply_rope(kr[:, :, None, :], cos, sin)[:, :, 0, :]
    scale = (D_NOPE + D_ROPE) ** -0.5
    kpos = jnp.arange(s_len)

    def step(i):
        q0 = i * MLA_QBLK
        qn = lax.dynamic_slice_in_dim(q_nope, q0, MLA_QBLK, axis=1)
        qr = lax.dynamic_slice_in_dim(q_rope, q0, MLA_QBLK, axis=1)
        s = (jnp.einsum('bqhn,bkhn->bhqk', qn, k_nope, preferred_element_type=F32)
             + jnp.einsum('bqhr,bkr->bhqk', qr, k_rope, preferred_element_type=F32)) * scale
        qpos = q0 + jnp.arange(MLA_QBLK)
        s = jnp.where(kpos[None, :] <= qpos[:, None], s, -jnp.inf)
        p = jax.nn.softmax(s, axis=-1).astype(v.dtype)
        return jnp.einsum('bhqk,bkhd->bqhd', p, v)

    outs = lax.map(step, jnp.arange(s_len // MLA_QBLK))
    return outs.transpose(1, 0, 2, 3, 4).reshape(bsz, s_len, D_HEADS * D_V)


def hybrid_layer(x, g_pre_mix, w_in, a_ln_g, a_ln_b, a_w_s, a_b_s, c_w_conv,
                 d_q_norm_g, d_w_uq, d_kv_norm_g, d_w_ukv, w_branch, w_out, g_post_mix,
                 g_pre_mlp, w_mlp_in, w_mlp_out, g_post_mlp, cos_b, sin_b, cos_d, sin_d):
    bsz, s_len, _ = x.shape
    h = rms_norm(x, g_pre_mix)
    (a_u, a_v, b_q, b_k, b_v, c_b, c_c, c_x,
     d_cq, d_ckv, d_kr, gate_logits) = split_columns(h @ w_in)

    out_a = chunked_sgu(jax.nn.gelu(a_u), jax.nn.gelu(a_v), a_ln_g, a_ln_b, a_w_s, a_b_s)
    hs = (bsz, s_len, B_HEADS, B_HEAD_DIM)
    out_b = moba_attention(partial_rope(b_q.reshape(hs), cos_b, sin_b),
                           partial_rope(b_k.reshape(hs), cos_b, sin_b),
                           b_v.reshape(hs))
    out_c = short_conv_mixer(c_b, c_c, c_x, c_w_conv)
    out_d = mla_attention(d_cq, d_ckv, d_kr, d_q_norm_g, d_w_uq, d_kv_norm_g, d_w_ukv, cos_d, sin_d)

    gates = jax.nn.sigmoid(gate_logits.reshape(bsz, s_len, N_BRANCH, D_MODEL))
    branches = (out_a, out_b, out_c, out_d)
    merged = gates[:, :, 0, :] * (branches[0] @ w_branch[0])
    for i in range(1, N_BRANCH):
        merged = merged + gates[:, :, i, :] * (branches[i] @ w_branch[i])
    x = x + rms_norm(merged @ w_out, g_post_mix)

    h = rms_norm(x, g_pre_mlp)
    y = jnp.square(jax.nn.relu(h @ w_mlp_in)) @ w_mlp_out
    return x + rms_norm(y, g_post_mlp)


def setup_inputs(seed: int = 0) -> dict:
    key = jax.random.key(seed)
    ks = jax.random.split(key, 20)
    L = DEPTH

    def nrm(k, shape, fan_in):
        return jax.random.normal(k, shape, F32) * (fan_in ** -0.5)

    def gain(k, shape):
        return 1.0 + 0.05 * jax.random.normal(k, shape, F32)

    return {
        'x': jax.random.normal(ks[0], (BATCH, SEQ, D_MODEL), F32),
        'g_pre_mix': gain(ks[1], (L, D_MODEL)),
        'w_in': nrm(ks[2], (L, D_MODEL, IN_COLS), D_MODEL),
        'a_ln_g': gain(ks[3], (L, A_WIDTH)),
        'a_ln_b': 0.02 * jax.random.normal(ks[4], (L, A_WIDTH), F32),
        'a_w_s': nrm(ks[5], (L, A_GROUPS, A_CHUNK, A_CHUNK), A_CHUNK),
        'a_b_s': gain(ks[6], (L, A_GROUPS, A_CHUNK)),
        'c_w_conv': nrm(ks[7], (L, CONV_WIDTH, C_WIDTH), CONV_WIDTH),
        'd_q_norm_g': gain(ks[8], (L, D_Q_LORA)),
        'd_w_uq': nrm(ks[9], (L, D_Q_LORA, D_HEADS, D_NOPE + D_ROPE), D_Q_LORA),
        'd_kv_norm_g': gain(ks[10], (L, D_KV_LORA)),
        'd_w_ukv': nrm(ks[11], (L, D_KV_LORA, D_HEADS, D_NOPE + D_V), D_KV_LORA),
        'w_branch': nrm(ks[12], (L, N_BRANCH, MIX_WIDTH, D_MODEL), MIX_WIDTH),
        'w_out': nrm(ks[13], (L, D_MODEL, D_MODEL), D_MODEL),
        'g_post_mix': gain(ks[14], (L, D_MODEL)),
        'g_pre_mlp': gain(ks[15], (L, D_MODEL)),
        'w_mlp_in': nrm(ks[16], (L, D_MODEL, D_FF), D_MODEL),
        'w_mlp_out': nrm(ks[17], (L, D_FF, D_MODEL), D_FF),
        'g_post_mlp': gain(ks[18], (L, D_MODEL)),
    }


def reference(x, g_pre_mix, w_in, a_ln_g, a_ln_b, a_w_s, a_b_s, c_w_conv,
              d_q_norm_g, d_w_uq, d_kv_norm_g, d_w_ukv, w_branch, w_out, g_post_mix,
              g_pre_mlp, w_mlp_in, w_mlp_out, g_post_mlp):
    s_len = x.shape[1]
    cos_b, sin_b = rope_tables(B_ROT_DIM, s_len)
    cos_d, sin_d = rope_tables(D_ROPE, s_len)
    for l in range(DEPTH):
        x = hybrid_layer(x, g_pre_mix[l], w_in[l], a_ln_g[l], a_ln_b[l], a_w_s[l], a_b_s[l],
                         c_w_conv[l], d_q_norm_g[l], d_w_uq[l], d_kv_norm_g[l], d_w_ukv[l],
                         w_branch[l], w_out[l], g_post_mix[l], g_pre_mlp[l], w_mlp_in[l],
                         w_mlp_out[l], g_post_mlp[l], cos_b, sin_b, cos_d, sin_d)
    return x
```

```cpp
#include <hip/hip_runtime.h>
#include <hip/hip_cooperative_groups.h>
#include <cstdio>
#include <cstdint>
#include <cmath>
namespace cg = cooperative_groups;

#define LAS __attribute__((address_space(3)))
typedef unsigned short bf16_t;
typedef short bf16x8 __attribute__((ext_vector_type(8)));
typedef short s16x4 __attribute__((ext_vector_type(4)));
typedef float f32x4 __attribute__((ext_vector_type(4)));
typedef float f32x2 __attribute__((ext_vector_type(2)));
typedef float f32x16 __attribute__((ext_vector_type(16)));
typedef unsigned u32x4 __attribute__((ext_vector_type(4)));
typedef unsigned u32x2 __attribute__((ext_vector_type(2)));
typedef __bf16 bf16x2_t __attribute__((ext_vector_type(2)));
#define DI __device__ __forceinline__

constexpr int T = 65536, DM = 1024, SEQ = 4096, NPANEL = 256, NL = 4, INC = 6496, DFF = 4096;
constexpr float EPS = 1e-6f;
constexpr float LOG2E = 1.4426950408889634f;
constexpr float C2M = 0.125f * LOG2E;
constexpr float C2D = 0.10206207261596575f * LOG2E;

constexpr size_t SZ_WIN = 2560ull * 1024 * 2, SZ_WG = 4096ull * 1024 * 2, SZ_WB = 4096ull * 256 * 2, SZ_WOUT = 1024ull * 1024 * 2,
                 SZ_W1 = 4096ull * 1024 * 2, SZ_W2 = 1024ull * 4096 * 2, SZ_WUQ = 512ull * 256 * 2, SZ_WUKV = 512ull * 128 * 2, SZ_WS = 4ull * 128 * 128 * 2;
constexpr size_t OW_IN = 0, OW_G = OW_IN + SZ_WIN, OW_B = OW_G + SZ_WG, OW_OUT = OW_B + SZ_WB, OW_1 = OW_OUT + SZ_WOUT, OW_2 = OW_1 + SZ_W1,
                 OW_UQ = OW_2 + SZ_W2, OW_UKV = OW_UQ + SZ_WUQ, OW_S = OW_UKV + SZ_WUKV, W_LAYER = OW_S + SZ_WS;
constexpr size_t WS_W = 0;
constexpr size_t WS_TAB = WS_W + NL * W_LAYER;
constexpr size_t TB_COSB = 0, TB_SINB = 131072, TB_COSD = 262144, TB_SIND = 524288, SZ_TAB = 786432;
constexpr size_t WS_RS0 = WS_TAB + SZ_TAB, WS_RS1 = WS_RS0 + 262144, WS_RSQ = WS_RS1 + 262144, WS_RSKV = WS_RSQ + 262144;
constexpr size_t WS_KPART = WS_RSKV + 262144;
constexpr size_t WS_XB = WS_KPART + 524288;
constexpr size_t WS_P = WS_XB + (size_t)T * DM * 2;
constexpr size_t BUFB = 256ull * 256 * 2, PSTRIDE = 10 * BUFB;
constexpr size_t WS_U = WS_P + NPANEL * PSTRIDE;
constexpr size_t USTRIDE = PSTRIDE;
constexpr size_t WS_END = WS_U + NPANEL * USTRIDE;
constexpr size_t U_QD = 0, U_KD = 196608, U_VD = 327680;
constexpr size_t U_G = 0, U_M = 524288, U_MERGED = 786432;
enum { B_AU = 0, B_BQ = 1, B_CB = 2, B_CQ = 3, B_AV = 4, B_BK = 5, B_BV = 6, B_CC = 7, B_CX = 8, B_CKV = 9 };

constexpr int RING_BYTES = 131072, LDS_BYTES = 147456;

DI int opaque_tid() { int t = threadIdx.x; asm volatile("" : "+v"(t)); return t; }
DI unsigned cvtpk(float lo, float hi) { f32x2 v = {lo, hi}; bf16x2_t b = __builtin_convertvector(v, bf16x2_t); return __builtin_bit_cast(unsigned, b); }
DI float bf2f(short s) { return __uint_as_float(((unsigned)(unsigned short)s) << 16); }
DI float wave_sum(float v) {
#pragma unroll
    for (int o = 1; o < 64; o <<= 1) v += __shfl_xor(v, o);
    return v;
}
DI float gelu_tanh(float v) {
    const float z = 0.7978845608028654f * (v + 0.044715f * v * v * v);
    return v * __builtin_amdgcn_rcpf(1.f + __builtin_amdgcn_exp2f(-2.f * LOG2E * z));
}
DI float sigmoidf_(float v) { return __builtin_amdgcn_rcpf(1.f + __builtin_amdgcn_exp2f(-LOG2E * v)); }

namespace pg8 {
constexpr int BM = 256, BK = 64, HALF = 128, HTB = HALF * BK * 2;
DI int lds_byte(int r, int c) { const int st = (r >> 4) * 2 + (c >> 5), rr = r & 15, cc = c & 31, ob = rr * 64 + cc * 2; return st * 1024 + (ob ^ (((ob >> 9) & 1) << 5)); }
DI void stage_rc(int b, int& R, int& C) { const int st = b / 1024, sb = b % 1024, swz = sb ^ (((sb >> 9) & 1) << 5); R = (st >> 1) * 16 + swz / 64; C = (st & 1) * 32 + (swz % 64) / 2; }
DI int perm32(int rho) { const int n = rho >> 4, i = rho & 15; return 8 * (i >> 2) + 4 * n + (i & 3); }
struct Unit { int pm, pn; };
struct Gemm { const bf16_t* A; const bf16_t* Bt; int lda, ldb, K; };
struct Seq { int n, pm0, pms, pn0, pns;
    DI bool next(int i, Unit& u) const { if (i >= n) return false; u.pm = pm0 + i * pms; u.pn = pn0 + i * pns; return true; } };

template <class Epi>
DI void gemm_phase(LAS unsigned char* lds, const Gemm g, const Seq& S_in, const Epi& E) {
    Seq S = S_in; asm volatile("" : "+s"(S.n));
    const int tid = opaque_tid(), wid = __builtin_amdgcn_readfirstlane(tid >> 6), lane = tid & 63, wr = wid >> 2, wc = wid & 3, fr = lane & 15, fq = lane >> 4;
    int K = g.K; asm volatile("" : "+s"(K)); const int nt = K / BK;
    unsigned voffA[2], voffB[2];
#pragma unroll
    for (int i = 0; i < 2; ++i) { int R, C; stage_rc(tid * 16 + i * 8192, R, C); const int Rb = Epi::PERM ? ((R & ~31) + perm32(R & 31)) : R;
        voffA[i] = (unsigned)(R * g.lda + C) * 2u; voffB[i] = (unsigned)(Rb * g.ldb + C) * 2u; }
    const size_t kstep = (size_t)(BK * 2);
    const size_t hstepA = (size_t)HALF * g.lda * 2, hstepB = (size_t)HALF * g.ldb * 2;
    const size_t tstepA = 2 * hstepA, tstepB = 2 * hstepB;
    const unsigned ldsw = (unsigned)wid * 1024u;
    const int aoff = lds_byte(wr * 64 + fr, fq * 8), boff = lds_byte(wc * 32 + fr, fq * 8);
#define PG8_SA(b, h) (((b) * 2 + (h)) * HTB)
#define PG8_SB(b, h) ((4 + (b) * 2 + (h)) * HTB)
#define PG8_STAGE(bufoff, gbase, voff) do { _Pragma("unroll") for (int _i = 0; _i < 2; ++_i) \
        __builtin_amdgcn_global_load_lds((const unsigned*)((const char*)(gbase) + (voff)[_i]), (LAS unsigned*)(lds + (bufoff) + ldsw + _i * 8192), 16, 0, 0); } while (0)
#define PG8_LDA(dst, b, h) do { _Pragma("unroll") for (int m = 0; m < 4; ++m) _Pragma("unroll") for (int k = 0; k < 2; ++k) dst[m][k] = *(const LAS bf16x8*)(lds + PG8_SA(b, h) + aoff + m * 2048 + k * 1024); } while (0)
#define PG8_LDB(dst, b, h) do { _Pragma("unroll") for (int n = 0; n < 2; ++n) _Pragma("unroll") for (int k = 0; k < 2; ++k) dst[n][k] = *(const LAS bf16x8*)(lds + PG8_SB(b, h) + boff + n * 2048 + k * 1024); } while (0)
#define PG8_MMA(ai, bj, At, Bt) do { __builtin_amdgcn_s_setprio(1); _Pragma("unroll") for (int m = 0; m < 4; ++m) _Pragma("unroll") for (int n = 0; n < 2; ++n) _Pragma("unroll") for (int k = 0; k < 2; ++k) \
        acc[ai][bj][m][n] = __builtin_amdgcn_mfma_f32_16x16x32_bf16(Bt[n][k], At[m][k], acc[ai][bj][m][n], 0, 0, 0); __builtin_amdgcn_s_setprio(0); } while (0)
#define PG8_WAIT_V(n) asm volatile("s_waitcnt vmcnt(" #n ")" ::: "memory")
#define PG8_WAIT_L(n) asm volatile("s_waitcnt lgkmcnt(" #n ")" ::: "memory")
#define PG8_BAR __builtin_amdgcn_s_barrier()
#define PG8_SCHED __builtin_amdgcn_sched_barrier(0)
    Unit cur, nxt; int ui = 0;
    if (!S.next(0, cur)) return;
    f32x4 acc[2][2][4][2];
#pragma unroll
    for (int a = 0; a < 2; ++a)
#pragma unroll
        for (int b = 0; b < 2; ++b)
#pragma unroll
            for (int m = 0; m < 4; ++m)
#pragma unroll
                for (int n = 0; n < 2; ++n) acc[a][b][m][n] = (f32x4){0.f, 0.f, 0.f, 0.f};
    bf16x8 At[4][2], B0[2][2], B1[2][2];
    const char* cA = (const char*)g.A + (size_t)cur.pm * tstepA; const char* cB = (const char*)g.Bt + (size_t)cur.pn * tstepB;
    PG8_STAGE(PG8_SB(0, 0), cB, voffB); PG8_STAGE(PG8_SB(0, 1), cB + hstepB, voffB); PG8_STAGE(PG8_SA(0, 0), cA, voffA); PG8_STAGE(PG8_SA(0, 1), cA + hstepA, voffA);
    if (wr == 1) PG8_BAR;
    PG8_WAIT_V(2); PG8_BAR;
    PG8_STAGE(PG8_SB(1, 0), cB + kstep, voffB); PG8_STAGE(PG8_SA(1, 0), cA + kstep, voffA); PG8_STAGE(PG8_SB(1, 1), cB + hstepB + kstep, voffB);
    PG8_WAIT_V(6); PG8_BAR;
    for (;;) {
        const bool has_next = S.next(ui + 1, nxt);
        const char* nA = has_next ? (const char*)g.A + (size_t)nxt.pm * tstepA : cA; const char* nB = has_next ? (const char*)g.Bt + (size_t)nxt.pn * tstepB : cB;
#pragma nounroll
        for (int t = 0; t < nt; t += 2) {
            const bool last = (t == nt - 2);
            const char* a1 = cA + (size_t)(t + 1) * kstep;
            const char* a2 = last ? nA : cA + (size_t)(t + 2) * kstep; const char* b2 = last ? nB : cB + (size_t)(t + 2) * kstep;
            const char* a3 = a2 + kstep; const char* b3 = b2 + kstep;
            PG8_LDB(B0, 0, 0); PG8_LDB(B1, 0, 1); PG8_SCHED; PG8_LDA(At, 0, 0); PG8_STAGE(PG8_SA(1, 1), a1 + hstepA, voffA);
            PG8_WAIT_V(8); PG8_WAIT_L(0); PG8_BAR; PG8_MMA(0, 0, At, B0); PG8_MMA(0, 1, At, B1); PG8_BAR; PG8_SCHED;
            PG8_LDA(At, 0, 1); PG8_STAGE(PG8_SB(0, 0), b2, voffB); PG8_STAGE(PG8_SB(0, 1), b2 + hstepB, voffB); PG8_STAGE(PG8_SA(0, 0), a2, voffA);
            PG8_WAIT_V(8); PG8_WAIT_L(0); PG8_BAR; PG8_MMA(1, 0, At, B0); PG8_MMA(1, 1, At, B1); PG8_BAR; PG8_SCHED;
            PG8_LDB(B0, 1, 0); PG8_LDB(B1, 1, 1); PG8_SCHED; PG8_LDA(At, 1, 0); PG8_STAGE(PG8_SA(0, 1), a2 + hstepA, voffA);
            PG8_WAIT_V(8); PG8_WAIT_L(0); PG8_BAR; PG8_MMA(0, 0, At, B0); PG8_MMA(0, 1, At, B1); PG8_BAR; PG8_SCHED;
            PG8_LDA(At, 1, 1); PG8_STAGE(PG8_SB(1, 0), b3, voffB); PG8_STAGE(PG8_SB(1, 1), b3 + hstepB, voffB); PG8_STAGE(PG8_SA(1, 0), a3, voffA);
            PG8_WAIT_V(8); PG8_WAIT_L(0); PG8_BAR; PG8_MMA(1, 0, At, B0); PG8_MMA(1, 1, At, B1); PG8_BAR; PG8_SCHED;
        }
        if (wr == 0) PG8_BAR;
        E(acc, cur, wr, wc, fr, fq);
        if (!has_next) break;
#pragma unroll
        for (int a = 0; a < 2; ++a)
#pragma unroll
            for (int b = 0; b < 2; ++b)
#pragma unroll
                for (int m = 0; m < 4; ++m)
#pragma unroll
                    for (int n = 0; n < 2; ++n) acc[a][b][m][n] = (f32x4){0.f, 0.f, 0.f, 0.f};
        cur = nxt; cA = nA; cB = nB; ++ui;
        if (wr == 1) PG8_BAR;
    }
    PG8_WAIT_V(0);
    PG8_BAR;
#undef PG8_SA
#undef PG8_SB
#undef PG8_STAGE
#undef PG8_LDA
#undef PG8_LDB
#undef PG8_MMA
#undef PG8_WAIT_V
#undef PG8_WAIT_L
#undef PG8_BAR
#undef PG8_SCHED
}
}
using pg8::Unit;
typedef f32x4 Acc[2][2][4][2];

struct EpiInProj {
    static constexpr bool PERM = true;
    bf16_t* Pp; const float* rs; const float* cosb; const float* sinb; const float* cosd; const float* sind; float* kpart; int pos0;
    DI void operator()(const Acc& acc, const Unit& u, int wr, int wc, int fr, int fq) const {
        asm volatile("" : "+v"(fr), "+v"(fq));
        const int tile = u.pn; bf16_t* dst = Pp + (size_t)tile * 65536;
        const bool act = (tile == B_AU) || (tile == B_AV);
        const bool rope16 = ((tile == B_BQ) || (tile == B_BK)) && ((wc & 1) == 0);
        const float qs = (tile == B_BQ) ? C2M : 1.f;
        float csum[2][8];
#pragma unroll
        for (int bj = 0; bj < 2; ++bj)
#pragma unroll
            for (int e = 0; e < 8; ++e) csum[bj][e] = 0.f;
#pragma unroll
        for (int ai = 0; ai < 2; ++ai)
#pragma unroll
            for (int m = 0; m < 4; ++m) {
                const int row = ai * 128 + wr * 64 + m * 16 + fr; const float r = rs[row] * qs; const int pos = pos0 + row;
#pragma unroll
                for (int bj = 0; bj < 2; ++bj) {
                    const int c0 = bj * 128 + wc * 32 + fq * 8;
                    float v[8];
#pragma unroll
                    for (int e = 0; e < 8; ++e) v[e] = acc[ai][bj][m][e >> 2][e & 3] * r;
                    if (act) {
#pragma unroll
                        for (int e = 0; e < 8; ++e) v[e] = gelu_tanh(v[e]);
                    }
                    if (rope16) {
                        const f32x4 ca = *(const f32x4*)(cosb + pos * 8), cb2 = *(const f32x4*)(cosb + pos * 8 + 4);
                        const f32x4 sa = *(const f32x4*)(sinb + pos * 8), sb2 = *(const f32x4*)(sinb + pos * 8 + 4);
#pragma unroll
                        for (int e = 0; e < 8; ++e) { const float o = __shfl_xor(v[e], 16); const float c = e < 4 ? ca[e & 3] : cb2[e & 3], s = e < 4 ? sa[e & 3] : sb2[e & 3];
                            const float rot = (fq == 0) ? (v[e] * c - o * s) : (v[e] * c + o * s); if (fq < 2) v[e] = rot; }
                    }
                    if (tile == B_CKV && bj == 1 && wc == 0) {
                        const int ib = 8 * (fq & 1);
                        const f32x4 ca = *(const f32x4*)(cosd + pos * 16 + ib), cb2 = *(const f32x4*)(cosd + pos * 16 + ib + 4);
                        const f32x4 sa = *(const f32x4*)(sind + pos * 16 + ib), sb2 = *(const f32x4*)(sind + pos * 16 + ib + 4);
#pragma unroll
                        for (int e = 0; e < 8; ++e) { const float o = __shfl_xor(v[e], 32); const float c = e < 4 ? ca[e & 3] : cb2[e & 3], s = e < 4 ? sa[e & 3] : sb2[e & 3];
                            v[e] = (fq < 2) ? (v[e] * c - o * s) : (v[e] * c + o * s); }
                    }
                    if (tile == B_BK) {
#pragma unroll
                        for (int e = 0; e < 8; ++e) csum[bj][e] += v[e];
                    }
                    u32x4 w; w.x = cvtpk(v[0], v[1]); w.y = cvtpk(v[2], v[3]); w.z = cvtpk(v[4], v[5]); w.w = cvtpk(v[6], v[7]);
                    *(u32x4*)(dst + row * 256 + c0) = w;
                }
                asm volatile("" ::: "memory");
            }
        if (tile == B_BK) {
#pragma unroll
            for (int bj = 0; bj < 2; ++bj)
#pragma unroll
                for (int e = 0; e < 8; ++e) { float s = csum[bj][e]; s += __shfl_xor(s, 1); s += __shfl_xor(s, 2); s += __shfl_xor(s, 4); s += __shfl_xor(s, 8);
                    if (fr == 0) kpart[wr * 256 + bj * 128 + wc * 32 + fq * 8 + e] = s; }
        }
    }
};
struct EpiUpQ {
    static constexpr bool PERM = true;
    bf16_t* Qp; const float* rsq; const float* cosd; const float* sind; int pos0;
    DI void operator()(const Acc& acc, const Unit& u, int wr, int wc, int fr, int fq) const {
        asm volatile("" : "+v"(fr), "+v"(fq));
        const int tile = u.pn;
#pragma unroll
        for (int ai = 0; ai < 2; ++ai)
#pragma unroll
            for (int m = 0; m < 4; ++m) {
                const int row = ai * 128 + wr * 64 + m * 16 + fr; const float r = rsq[row] * C2D; const int pos = pos0 + row;
#pragma unroll
                for (int bj = 0; bj < 2; ++bj) {
                    float v[8];
#pragma unroll
                    for (int e = 0; e < 8; ++e) v[e] = acc[ai][bj][m][e >> 2][e & 3] * r;
                    if (tile == 0) {
                        const int c0 = bj * 128 + wc * 32 + fq * 8, head = c0 >> 6, e0 = c0 & 63;
                        u32x4 w; w.x = cvtpk(v[0], v[1]); w.y = cvtpk(v[2], v[3]); w.z = cvtpk(v[4], v[5]); w.w = cvtpk(v[6], v[7]);
                        *(u32x4*)(Qp + row * 384 + head * 96 + e0) = w;
                    } else if (bj == 0) {
                        const int ib = 8 * (fq & 1);
                        const f32x4 ca = *(const f32x4*)(cosd + pos * 16 + ib), cb2 = *(const f32x4*)(cosd + pos * 16 + ib + 4);
                        const f32x4 sa = *(const f32x4*)(sind + pos * 16 + ib), sb2 = *(const f32x4*)(sind + pos * 16 + ib + 4);
#pragma unroll
                        for (int e = 0; e < 8; ++e) { const float o = __shfl_xor(v[e], 32); const float c = e < 4 ? ca[e & 3] : cb2[e & 3], s = e < 4 ? sa[e & 3] : sb2[e & 3];
                            v[e] = (fq < 2) ? (v[e] * c - o * s) : (v[e] * c + o * s); }
                        u32x4 w; w.x = cvtpk(v[0], v[1]); w.y = cvtpk(v[2], v[3]); w.z = cvtpk(v[4], v[5]); w.w = cvtpk(v[6], v[7]);
                        *(u32x4*)(Qp + row * 384 + wc * 96 + 64 + fq * 8) = w;
                    }
                }
                asm volatile("" ::: "memory");
            }
    }
};
struct EpiUpKV {
    static constexpr bool PERM = true;
    bf16_t* Kp; bf16_t* Vp; const float* rskv;
    DI void operator()(const Acc& acc, const Unit& u, int wr, int wc, int fr, int fq) const {
        asm volatile("" : "+v"(fr), "+v"(fq));
        bf16_t* dst = u.pn == 0 ? Kp : Vp;
#pragma unroll
        for (int ai = 0; ai < 2; ++ai)
#pragma unroll
            for (int m = 0; m < 4; ++m) {
                const int row = ai * 128 + wr * 64 + m * 16 + fr; const float r = rskv[row];
#pragma unroll
                for (int bj = 0; bj < 2; ++bj) {
                    const int c0 = bj * 128 + wc * 32 + fq * 8; float v[8];
#pragma unroll
                    for (int e = 0; e < 8; ++e) v[e] = acc[ai][bj][m][e >> 2][e & 3] * r;
                    u32x4 w; w.x = cvtpk(v[0], v[1]); w.y = cvtpk(v[2], v[3]); w.z = cvtpk(v[4], v[5]); w.w = cvtpk(v[6], v[7]);
                    *(u32x4*)(dst + row * 256 + c0) = w;
                }
                asm volatile("" ::: "memory");
            }
    }
};
struct EpiG {
    static constexpr bool PERM = true;
    unsigned char* Gs; const float* rs;
    DI void operator()(const Acc& acc, const Unit& u, int wr, int wc, int fr, int fq) const {
        asm volatile("" : "+v"(fr), "+v"(fq));
        const int br = u.pn >> 2; u32x4* g = (u32x4*)(Gs + (size_t)br * 131072) + opaque_tid();
#pragma unroll
        for (int ai = 0; ai < 2; ++ai)
#pragma unroll
            for (int m = 0; m < 4; ++m) {
                const int row = ai * 128 + wr * 64 + m * 16 + fr; const float r = rs[row];
#pragma unroll
                for (int bj = 0; bj < 2; ++bj) {
                    float v[8];
#pragma unroll
                    for (int e = 0; e < 8; ++e) v[e] = sigmoidf_(acc[ai][bj][m][e >> 2][e & 3] * r);
                    u32x4 w; w.x = cvtpk(v[0], v[1]); w.y = cvtpk(v[2], v[3]); w.z = cvtpk(v[4], v[5]); w.w = cvtpk(v[6], v[7]);
                    g[((ai * 2 + bj) * 4 + m) * 512] = w;
                }
                asm volatile("" ::: "memory");
            }
    }
};
struct EpiY {
    static constexpr bool PERM = true;
    unsigned char* Gs; unsigned char* Ms; bf16_t* merged; int pnn;
    DI void operator()(const Acc& acc, const Unit& u, int wr, int wc, int fr, int fq) const {
        asm volatile("" : "+v"(fr), "+v"(fq));
        const int br = u.pm; const int tq = opaque_tid(); const u32x4* g = (const u32x4*)(Gs + (size_t)br * 131072) + tq; f32x4* ms = (f32x4*)Ms + tq;
#pragma unroll
        for (int ai = 0; ai < 2; ++ai)
#pragma unroll
            for (int m = 0; m < 4; ++m) {
                const int row = ai * 128 + wr * 64 + m * 16 + fr;
#pragma unroll
                for (int bj = 0; bj < 2; ++bj) {
                    const int k = (ai * 2 + bj) * 4 + m; const u32x4 gw = g[k * 512];
                    float gt[8]; gt[0] = __uint_as_float(gw.x << 16); gt[1] = __uint_as_float(gw.x & 0xffff0000u); gt[2] = __uint_as_float(gw.y << 16); gt[3] = __uint_as_float(gw.y & 0xffff0000u);
                    gt[4] = __uint_as_float(gw.z << 16); gt[5] = __uint_as_float(gw.z & 0xffff0000u); gt[6] = __uint_as_float(gw.w << 16); gt[7] = __uint_as_float(gw.w & 0xffff0000u);
                    f32x4 v0, v1;
#pragma unroll
                    for (int e = 0; e < 4; ++e) { v0[e] = acc[ai][bj][m][0][e] * gt[e]; v1[e] = acc[ai][bj][m][1][e] * gt[4 + e]; }
                    if (br > 0) { v0 += ms[(2 * k) * 512]; v1 += ms[(2 * k + 1) * 512]; }
                    if (br < 3) { ms[(2 * k) * 512] = v0; ms[(2 * k + 1) * 512] = v1; }
                    else { const int c0 = pnn * 256 + bj * 128 + wc * 32 + fq * 8;
                        u32x4 w; w.x = cvtpk(v0[0], v0[1]); w.y = cvtpk(v0[2], v0[3]); w.z = cvtpk(v1[0], v1[1]); w.w = cvtpk(v1[2], v1[3]);
                        *(u32x4*)(merged + row * 1024 + c0) = w; }
                }
                asm volatile("" ::: "memory");
            }
    }
};
struct EpiF32 {
    static constexpr bool PERM = false;
    float* Y; int accum;
    DI void operator()(const Acc& acc, const Unit& u, int wr, int wc, int fr, int fq) const {
        asm volatile("" : "+v"(fr), "+v"(fq));
#pragma unroll
        for (int ai = 0; ai < 2; ++ai)
#pragma unroll
            for (int m = 0; m < 4; ++m) {
                const int row = ai * 128 + wr * 64 + m * 16 + fr;
#pragma unroll
                for (int bj = 0; bj < 2; ++bj)
#pragma unroll
                    for (int n = 0; n < 2; ++n) { f32x4* p = (f32x4*)(Y + row * 1024 + u.pn * 256 + bj * 128 + wc * 32 + n * 16 + fq * 4);
                        f32x4 v = acc[ai][bj][m][n]; if (accum) v += *p; *p = v; }
                asm volatile("" ::: "memory");
            }
    }
};
struct EpiMlpIn {
    static constexpr bool PERM = true;
    bf16_t* Uo; const float* rs; int pn_base;
    DI void operator()(const Acc& acc, const Unit& u, int wr, int wc, int fr, int fq) const {
        asm volatile("" : "+v"(fr), "+v"(fq));
        const int ct = (u.pn - pn_base) * 256;
#pragma unroll
        for (int ai = 0; ai < 2; ++ai)
#pragma unroll
            for (int m = 0; m < 4; ++m) {
                const int row = ai * 128 + wr * 64 + m * 16 + fr; const float r = rs[row];
#pragma unroll
                for (int bj = 0; bj < 2; ++bj) {
                    const int c0 = ct + bj * 128 + wc * 32 + fq * 8; float v[8];
#pragma unroll
                    for (int e = 0; e < 8; ++e) { const float t = fmaxf(acc[ai][bj][m][e >> 2][e & 3] * r, 0.f); v[e] = t * t; }
                    u32x4 w; w.x = cvtpk(v[0], v[1]); w.y = cvtpk(v[2], v[3]); w.z = cvtpk(v[4], v[5]); w.w = cvtpk(v[6], v[7]);
                    *(u32x4*)(Uo + row * 2048 + c0) = w;
                }
                asm volatile("" ::: "memory");
            }
    }
};

DI int crow(int r, int hi) { return (r & 3) + 8 * (r >> 2) + 4 * hi; }
#define MFMA32(a, b, c) __builtin_amdgcn_mfma_f32_32x32x16_bf16((a), (b), (c), 0, 0, 0)
template <int DQK, bool MOBA>
DI void attn_unit(int b, int h, int qb, unsigned char* P, unsigned char* U, const float* kpart, LAS unsigned char* lds) {
    constexpr int ND0 = DQK / 16, KSTR = DQK * 2 + 16, VSTR = 144;
    constexpr int L_K = 0, L_V = 13312, L_KM = 22528;
    constexpr float NEG = -1e30f;
    const int tid = opaque_tid(), lane = tid & 63, wid = __builtin_amdgcn_readfirstlane(tid >> 6), r = lane & 31, hh = lane >> 5;
    const int panel_q = b * 16 + qb;
    unsigned char* Pq = P + (size_t)panel_q * PSTRIDE; unsigned char* Uq = U + (size_t)panel_q * USTRIDE;
    const bf16_t* qrow = MOBA ? (const bf16_t*)(Pq + B_BQ * BUFB) + (32 * wid + r) * 256 + h * 64 : (const bf16_t*)(Uq + U_QD) + (32 * wid + r) * 384 + h * 96;
    bf16x8 qf[ND0];
#pragma unroll
    for (int d0 = 0; d0 < ND0; ++d0) qf[d0] = *(const bf16x8*)(qrow + 16 * d0 + 8 * hh);
    unsigned mask = 0xffffffffu;
    if (MOBA) {
        LAS float* km = (LAS float*)(lds + L_KM);
        __syncthreads();
        for (int idx = tid; idx < qb * 64; idx += 512) { const int n = idx >> 6, d = idx & 63; const float* kp = kpart + (size_t)(b * 16 + n) * 512 + h * 64 + d; km[idx] = (kp[0] + kp[256]) * (1.f / 256.f); }
        __syncthreads();
        if (qb <= 3) mask = (1u << qb) - 1u;
        else {
            float qv[ND0 * 8];
#pragma unroll
            for (int d0 = 0; d0 < ND0; ++d0)
#pragma unroll
                for (int j = 0; j < 8; ++j) qv[d0 * 8 + j] = bf2f(qf[d0][j]);
            float v1 = -INFINITY, v2 = -INFINITY, v3 = -INFINITY; int i1 = -1, i2 = -1, i3 = -1;
            for (int n = 0; n < qb; ++n) {
                float g = 0.f;
#pragma unroll
                for (int d0 = 0; d0 < ND0; ++d0)
#pragma unroll
                    for (int j = 0; j < 8; ++j) g += qv[d0 * 8 + j] * km[n * 64 + 16 * d0 + 8 * hh + j];
                g += __shfl_xor(g, 32);
                if (g > v1) { v3 = v2; i3 = i2; v2 = v1; i2 = i1; v1 = g; i1 = n; }
                else if (g > v2) { v3 = v2; i3 = i2; v2 = g; i2 = n; }
                else if (g > v3) { v3 = g; i3 = n; }
            }
            mask = (1u << i1) | (1u << i2) | (1u << i3);
        }
    }
    const int NT = 4 * (qb + 1);
    const int lkey = tid >> 3, lch = tid & 7;
    u32x4 kreg, vreg, kreg2 = (u32x4){0u, 0u, 0u, 0u};
#define ATT_LOAD(kt) do { const int kp_ = b * 16 + ((kt) >> 2), r0_ = 64 * ((kt) & 3); \
        const unsigned char* Pk_ = P + (size_t)kp_ * PSTRIDE; const unsigned char* Uk_ = U + (size_t)kp_ * USTRIDE; \
        const bf16_t* ks_ = MOBA ? (const bf16_t*)(Pk_ + B_BK * BUFB) : (const bf16_t*)(Uk_ + U_KD); \
        const bf16_t* vs_ = MOBA ? (const bf16_t*)(Pk_ + B_BV * BUFB) : (const bf16_t*)(Uk_ + U_VD); \
        kreg = *(const u32x4*)(ks_ + (r0_ + lkey) * 256 + h * 64 + 8 * lch); \
        vreg = *(const u32x4*)(vs_ + (r0_ + lkey) * 256 + h * 64 + 8 * lch); \
        if (!MOBA && tid < 256) kreg2 = *(const u32x4*)((const bf16_t*)(Pk_ + B_CKV * BUFB) + (r0_ + (tid >> 2)) * 256 + 128 + 8 * (tid & 3)); } while (0)
    float mrun = NEG, lrun = 0.f;
    f32x16 o0, o1;
#pragma unroll
    for (int i = 0; i < 16; ++i) { o0[i] = 0.f; o1[i] = 0.f; }
    ATT_LOAD(0);
    for (int kt = 0; kt < NT; ++kt) {
        __syncthreads();
        *(LAS u32x4*)(lds + L_K + lkey * KSTR + lch * 16) = kreg;
        if (!MOBA && tid < 256) *(LAS u32x4*)(lds + L_K + (tid >> 2) * KSTR + 128 + (tid & 3) * 16) = kreg2;
        {
            LAS unsigned short* vt = (LAS unsigned short*)(lds + L_V + (8 * lch) * VSTR + lkey * 2);
            vt[0 * (VSTR / 2)] = (unsigned short)(vreg.x & 0xffffu); vt[1 * (VSTR / 2)] = (unsigned short)(vreg.x >> 16);
            vt[2 * (VSTR / 2)] = (unsigned short)(vreg.y & 0xffffu); vt[3 * (VSTR / 2)] = (unsigned short)(vreg.y >> 16);
            vt[4 * (VSTR / 2)] = (unsigned short)(vreg.z & 0xffffu); vt[5 * (VSTR / 2)] = (unsigned short)(vreg.z >> 16);
            vt[6 * (VSTR / 2)] = (unsigned short)(vreg.w & 0xffffu); vt[7 * (VSTR / 2)] = (unsigned short)(vreg.w >> 16);
        }
        __syncthreads();
        if (kt + 1 < NT) ATT_LOAD(kt + 1);
        const int nblk = kt >> 2; const bool diag = (nblk == qb); const int kr0 = 64 * (kt & 3);
        if (diag && kr0 > 32 * wid + 31) continue;
        bool lane_sel = true;
        if (MOBA && !diag) { lane_sel = ((mask >> nblk) & 1u) != 0u; if (!__any(lane_sel)) continue; }
        f32x16 p0, p1;
#pragma unroll
        for (int i = 0; i < 16; ++i) { p0[i] = 0.f; p1[i] = 0.f; }
#pragma unroll
        for (int d0 = 0; d0 < ND0; ++d0) {
            const bf16x8 a0 = *(const LAS bf16x8*)(lds + L_K + r * KSTR + (16 * d0 + 8 * hh) * 2);
            const bf16x8 a1 = *(const LAS bf16x8*)(lds + L_K + (32 + r) * KSTR + (16 * d0 + 8 * hh) * 2);
            p0 = MFMA32(a0, qf[d0], p0); p1 = MFMA32(a1, qf[d0], p1);
        }
        if (diag) { const int qr = 32 * wid + r;
#pragma unroll
            for (int i = 0; i < 16; ++i) { const int kk = kr0 + crow(i, hh); if (kk > qr) p0[i] = NEG; if (kk + 32 > qr) p1[i] = NEG; } }
        if (MOBA && !diag && !lane_sel) {
#pragma unroll
            for (int i = 0; i < 16; ++i) { p0[i] = NEG; p1[i] = NEG; } }
        float mx = fmaxf(p0[0], p1[0]);
#pragma unroll
        for (int i = 1; i < 16; ++i) mx = fmaxf(mx, fmaxf(p0[i], p1[i]));
        mx = fmaxf(mx, __shfl_xor(mx, 32));
        const float mnew = fmaxf(mrun, mx), alpha = __builtin_amdgcn_exp2f(mrun - mnew); mrun = mnew;
        float ps = 0.f;
#pragma unroll
        for (int i = 0; i < 16; ++i) { p0[i] = __builtin_amdgcn_exp2f(p0[i] - mnew); p1[i] = __builtin_amdgcn_exp2f(p1[i] - mnew); ps += p0[i] + p1[i]; }
        lrun = lrun * alpha + ps;
#pragma unroll
        for (int i = 0; i < 16; ++i) { o0[i] *= alpha; o1[i] *= alpha; }
#pragma unroll
        for (int kh = 0; kh < 2; ++kh)
#pragma unroll
            for (int s = 0; s < 2; ++s) {
                u32x4 pw;
                if (kh == 0) { pw.x = cvtpk(p0[8 * s], p0[8 * s + 1]); pw.y = cvtpk(p0[8 * s + 2], p0[8 * s + 3]); pw.z = cvtpk(p0[8 * s + 4], p0[8 * s + 5]); pw.w = cvtpk(p0[8 * s + 6], p0[8 * s + 7]); }
                else { pw.x = cvtpk(p1[8 * s], p1[8 * s + 1]); pw.y = cvtpk(p1[8 * s + 2], p1[8 * s + 3]); pw.z = cvtpk(p1[8 * s + 4], p1[8 * s + 5]); pw.w = cvtpk(p1[8 * s + 6], p1[8 * s + 7]); }
                const bf16x8 pf = __builtin_bit_cast(bf16x8, pw);
                const int kb = (32 * kh + 16 * s + 4 * hh) * 2;
                {   const u32x2 lo = *(const LAS u32x2*)(lds + L_V + r * VSTR + kb), hi = *(const LAS u32x2*)(lds + L_V + r * VSTR + kb + 16);
                    const u32x4 vv = (u32x4){lo.x, lo.y, hi.x, hi.y}; o0 = MFMA32(__builtin_bit_cast(bf16x8, vv), pf, o0); }
                {   const u32x2 lo = *(const LAS u32x2*)(lds + L_V + (32 + r) * VSTR + kb), hi = *(const LAS u32x2*)(lds + L_V + (32 + r) * VSTR + kb + 16);
                    const u32x4 vv = (u32x4){lo.x, lo.y, hi.x, hi.y}; o1 = MFMA32(__builtin_bit_cast(bf16x8, vv), pf, o1); }
            }
    }
#undef ATT_LOAD
    lrun += __shfl_xor(lrun, 32);
    const float rl = 1.f / lrun;
    bf16_t* orow = (bf16_t*)(Pq + (MOBA ? B_BQ : B_CQ) * BUFB) + (32 * wid + r) * 256 + h * 64;
#pragma unroll
    for (int g4 = 0; g4 < 4; ++g4) {
        u32x2 w0, w1;
        w0.x = cvtpk(o0[4 * g4] * rl, o0[4 * g4 + 1] * rl); w0.y = cvtpk(o0[4 * g4 + 2] * rl, o0[4 * g4 + 3] * rl);
        w1.x = cvtpk(o1[4 * g4] * rl, o1[4 * g4 + 1] * rl); w1.y = cvtpk(o1[4 * g4 + 2] * rl, o1[4 * g4 + 3] * rl);
        *(u32x2*)(orow + 8 * g4 + 4 * hh) = w0; *(u32x2*)(orow + 32 + 8 * g4 + 4 * hh) = w1;
    }
}

struct Params {
    const float* x; const float* g_pre_mix; const float* w_in; const float* a_ln_g; const float* a_ln_b; const float* a_w_s; const float* a_b_s; const float* c_w_conv;
    const float* d_q_norm_g; const float* d_w_uq; const float* d_kv_norm_g; const float* d_w_ukv; const float* w_branch; const float* w_out; const float* g_post_mix;
    const float* g_pre_mlp; const float* w_mlp_in; const float* w_mlp_out; const float* g_post_mlp;
    float* out; unsigned char* ws;
    float invb[8]; float invd[16];
};

DI void norm_step(const float* y, const float* xsrc, float* xdst, bf16_t* xb, float* rs_out, const float* gain, int wid, int lane_) {
    int lane = lane_; asm volatile("" : "+v"(lane));
    for (int rr = 0; rr < 32; ++rr) {
        const int row = wid * 32 + rr; f32x4 yv[4], xv[4]; float ss = 0.f;
#pragma unroll
        for (int j = 0; j < 4; ++j) { yv[j] = *(const f32x4*)(y + row * 1024 + 4 * lane + 256 * j); xv[j] = *(const f32x4*)(xsrc + (size_t)row * 1024 + 4 * lane + 256 * j);
            ss += yv[j].x * yv[j].x + yv[j].y * yv[j].y + yv[j].z * yv[j].z + yv[j].w * yv[j].w; }
        const float ry = 1.0f / sqrtf(wave_sum(ss) * (1.f / 1024.f) + EPS); float s2 = 0.f;
#pragma unroll
        for (int j = 0; j < 4; ++j) { const f32x4 gv = *(const f32x4*)(gain + 4 * lane + 256 * j); const f32x4 xn = xv[j] + yv[j] * ry * gv;
            *(f32x4*)(xdst + (size_t)row * 1024 + 4 * lane + 256 * j) = xn; s2 += xn.x * xn.x + xn.y * xn.y + xn.z * xn.z + xn.w * xn.w;
            u32x2 w; w.x = cvtpk(xn.x, xn.y); w.y = cvtpk(xn.z, xn.w); *(u32x2*)(xb + (size_t)row * 1024 + 4 * lane + 256 * j) = w; }
        s2 = wave_sum(s2);
        if (lane == 0) rs_out[row] = 1.0f / sqrtf(s2 * (1.f / 1024.f) + EPS);
    }
}
DI void prep_panel(const float* xsrc, bf16_t* xb, float* rs_out, int wid, int lane_) {
    int lane = lane_; asm volatile("" : "+v"(lane));
    for (int rr = 0; rr < 32; ++rr) {
        const int row = wid * 32 + rr; float s2 = 0.f;
#pragma unroll
        for (int j = 0; j < 4; ++j) { const f32x4 xn = *(const f32x4*)(xsrc + (size_t)row * 1024 + 4 * lane + 256 * j); s2 += xn.x * xn.x + xn.y * xn.y + xn.z * xn.z + xn.w * xn.w;
            u32x2 w; w.x = cvtpk(xn.x, xn.y); w.y = cvtpk(xn.z, xn.w); *(u32x2*)(xb + (size_t)row * 1024 + 4 * lane + 256 * j) = w; }
        s2 = wave_sum(s2);
        if (lane == 0) rs_out[row] = 1.0f / sqrtf(s2 * (1.f / 1024.f) + EPS);
    }
}
struct TJob { const float* src; int src_ld, src_col0, nvalid, ksrc; bf16_t* dst; int ndst, kdst; const float* g; };
DI TJob get_job(const Params& p, int l, int j) {
    unsigned char* wl = p.ws + WS_W + (size_t)l * W_LAYER; TJob t;
    const float* win = p.w_in + (size_t)l * DM * INC;
    if (j < 10) {
        const int st[10] = {0, 512, 1280, 2048, 256, 768, 1024, 1536, 1792, 2240}; const int nv[10] = {256, 256, 256, 192, 256, 256, 256, 256, 256, 160};
        int s0 = 0, n0 = 0;
#pragma unroll
        for (int q = 0; q < 10; ++q) if (q == j) { s0 = st[q]; n0 = nv[q]; }
        t = TJob{win, INC, s0, n0, 1024, (bf16_t*)(wl + OW_IN) + (size_t)j * 256 * 1024, 256, 1024, p.g_pre_mix + l * DM};
    } else if (j == 10) t = TJob{win, INC, 2400, 4096, 1024, (bf16_t*)(wl + OW_G), 4096, 1024, p.g_pre_mix + l * DM};
    else if (j < 15) { const int i = j - 11; t = TJob{p.w_branch + ((size_t)l * 4 + i) * 256 * 1024, 1024, 0, 1024, 256, (bf16_t*)(wl + OW_B) + (size_t)i * 1024 * 256, 1024, 256, nullptr}; }
    else if (j == 15) t = TJob{p.w_out + (size_t)l * DM * DM, 1024, 0, 1024, 1024, (bf16_t*)(wl + OW_OUT), 1024, 1024, nullptr};
    else if (j == 16) t = TJob{p.w_mlp_in + (size_t)l * DM * DFF, DFF, 0, 4096, 1024, (bf16_t*)(wl + OW_1), 4096, 1024, p.g_pre_mlp + l * DM};
    else if (j == 17) t = TJob{p.w_mlp_out + (size_t)l * DFF * DM, 1024, 0, 1024, 4096, (bf16_t*)(wl + OW_2), 1024, 4096, nullptr};
    else if (j < 22) { const int h = j - 18; t = TJob{p.d_w_uq + (size_t)l * 192 * 384, 384, h * 96, 64, 192, (bf16_t*)(wl + OW_UQ) + (size_t)(h * 64) * 256, 64, 256, p.d_q_norm_g + l * 192}; }
    else if (j < 26) { const int h = j - 22; t = TJob{p.d_w_uq + (size_t)l * 192 * 384, 384, h * 96 + 64, 32, 192, (bf16_t*)(wl + OW_UQ) + (size_t)(256 + h * 32) * 256, 32, 256, p.d_q_norm_g + l * 192}; }
    else if (j == 26) t = TJob{p.d_w_uq, 384, 0, 0, 0, (bf16_t*)(wl + OW_UQ) + (size_t)384 * 256, 128, 256, nullptr};
    else if (j < 31) { const int h = j - 27; t = TJob{p.d_w_ukv + (size_t)l * 128 * 512, 512, h * 128, 64, 128, (bf16_t*)(wl + OW_UKV) + (size_t)(h * 64) * 128, 64, 128, p.d_kv_norm_g + l * 128}; }
    else { const int h = j - 31; t = TJob{p.d_w_ukv + (size_t)l * 128 * 512, 512, h * 128 + 64, 64, 128, (bf16_t*)(wl + OW_UKV) + (size_t)(256 + h * 64) * 128, 64, 128, p.d_kv_norm_g + l * 128}; }
    return t;
}
DI void transpose_item(const TJob& t, LAS float* scr, int item, int lane) {
    const int nn = t.ndst / 32, kb = item / nn, nb = item % nn, k0 = 64 * kb, n0 = 32 * nb;
    const bool valid = (k0 < t.ksrc) && (n0 < t.nvalid);
    const int c = lane & 7;
    if (valid) {
#pragma unroll 8
        for (int i = 0; i < 32; ++i) { const int kk = 2 * i + (lane >> 5); float v = t.src[(size_t)(k0 + kk) * t.src_ld + t.src_col0 + n0 + (lane & 31)]; if (t.g) v *= t.g[k0 + kk]; scr[kk * 33 + (lane & 31)] = v; }
        asm volatile("s_waitcnt lgkmcnt(0)" ::: "memory");
#pragma unroll
        for (int j = 0; j < 4; ++j) { const int n = (lane >> 3) + 8 * j; const LAS float* s = scr + (8 * c) * 33 + n;
            u32x4 o; o.x = cvtpk(s[0 * 33], s[1 * 33]); o.y = cvtpk(s[2 * 33], s[3 * 33]); o.z = cvtpk(s[4 * 33], s[5 * 33]); o.w = cvtpk(s[6 * 33], s[7 * 33]);
            *(u32x4*)(t.dst + (size_t)(n0 + n) * t.kdst + k0 + 8 * c) = o; }
        asm volatile("s_waitcnt lgkmcnt(0)" ::: "memory");
    } else {
#pragma unroll
        for (int j = 0; j < 4; ++j) { const int n = (lane >> 3) + 8 * j; *(u32x4*)(t.dst + (size_t)(n0 + n) * t.kdst + k0 + 8 * c) = (u32x4){0u, 0u, 0u, 0u}; }
    }
}
DI void sincos_d(float af, float& s_out, float& c_out) {
    const double a = (double)af; const double q = rint(a * 0.63661977236758134308);
    double r = fma(-q, 1.57079632679489655800e+00, a); r = fma(-q, 6.12323399573676603587e-17, r);
    const double r2 = r * r;
    double sp = -7.6471637318198164759e-13; sp = fma(sp, r2, 1.6059043836821614599e-10); sp = fma(sp, r2, -2.5052108385441718775e-08); sp = fma(sp, r2, 2.7557319223985890653e-06);
    sp = fma(sp, r2, -1.9841269841269841270e-04); sp = fma(sp, r2, 8.3333333333333333333e-03); sp = fma(sp, r2, -1.6666666666666666667e-01); const double sn = fma(sp * r2, r, r);
    double cp = 4.7794773323873852974e-14; cp = fma(cp, r2, -1.1470745597729724714e-11); cp = fma(cp, r2, 2.0876756987868098979e-09); cp = fma(cp, r2, -2.7557319223985890653e-07);
    cp = fma(cp, r2, 2.4801587301587301587e-05); cp = fma(cp, r2, -1.3888888888888888889e-03); cp = fma(cp, r2, 4.1666666666666666667e-02); cp = fma(cp, r2, -0.5); const double cs = fma(cp, r2, 1.0);
    const int qi = ((int)q) & 3;
    const double s = (qi == 0) ? sn : (qi == 1) ? cs : (qi == 2) ? -sn : -cs;
    const double c = (qi == 0) ? cs : (qi == 1) ? -sn : (qi == 2) ? -cs : sn;
    s_out = (float)s; c_out = (float)c;
}

__global__ void __launch_bounds__(512, 2) hybrid_fwd(Params p) {
    extern __shared__ __attribute__((aligned(16))) unsigned char lds_raw[];
    LAS unsigned char* lds = (LAS unsigned char*)lds_raw;
    cg::grid_group grid = cg::this_grid();
    const int tid = threadIdx.x, lane = tid & 63, wid = __builtin_amdgcn_readfirstlane(tid >> 6);
    const int G = gridDim.x, bx = blockIdx.x;
    unsigned char* ws = p.ws;
    float* cosb = (float*)(ws + WS_TAB + TB_COSB); float* sinb = (float*)(ws + WS_TAB + TB_SINB);
    float* cosd = (float*)(ws + WS_TAB + TB_COSD); float* sind = (float*)(ws + WS_TAB + TB_SIND);
    float* rs0 = (float*)(ws + WS_RS0); float* rs1 = (float*)(ws + WS_RS1); float* rsq = (float*)(ws + WS_RSQ); float* rskv = (float*)(ws + WS_RSKV);
    float* kpart = (float*)(ws + WS_KPART);
    bf16_t* xb = (bf16_t*)(ws + WS_XB);
    unsigned char* Pb = ws + WS_P; unsigned char* Ub = ws + WS_U;

    {
        LAS float* scr = (LAS float*)(lds + wid * 16384);
        const int gw = bx * 8 + wid, NGW = G * 8;
        for (int l = 0; l < NL; ++l)
            for (int j = 0; j < 35; ++j) { const TJob t = get_job(p, l, j); const int nit = (t.kdst / 64) * (t.ndst / 32);
                for (int it = gw; it < nit; it += NGW) transpose_item(t, scr, it, lane); }
        const int gt = bx * 512 + tid, NGT = G * 512;
        for (int idx = gt; idx < NL * 65536; idx += NGT) { const int l = idx >> 16, e = idx & 65535, tt = (e >> 7) & 127, s = e & 127;
            const float v = (s <= tt) ? p.a_w_s[idx] : 0.f; ((bf16_t*)(ws + WS_W + (size_t)l * W_LAYER + OW_S))[e] = (bf16_t)(cvtpk(v, 0.f) & 0xffffu); }
        for (int idx = gt; idx < SEQ * 8; idx += NGT) { const int pos = idx >> 3, i = idx & 7; const float ang = (float)pos * p.invb[i]; float s, c; sincos_d(ang, s, c); cosb[idx] = c; sinb[idx] = s; }
        for (int idx = gt; idx < SEQ * 16; idx += NGT) { const int pos = idx >> 4, i = idx & 15; const float ang = (float)pos * p.invd[i]; float s, c; sincos_d(ang, s, c); cosd[idx] = c; sind[idx] = s; }
        for (int panel = bx; panel < NPANEL; panel += G) prep_panel(p.x + (size_t)panel * 256 * DM, xb + (size_t)panel * 256 * DM, rs0 + panel * 256, wid, lane);
    }
    grid.sync();

    for (int l = 0; l < NL; ++l) {
        unsigned char* wl = ws + WS_W + (size_t)l * W_LAYER;
        for (int panel = bx; panel < NPANEL; panel += G) {
            unsigned char* Pp = Pb + (size_t)panel * PSTRIDE; unsigned char* Up = Ub + (size_t)panel * USTRIDE;
            const int pos0 = (panel & 15) * 256;
            {
                pg8::Gemm g{xb, (const bf16_t*)(wl + OW_IN), 1024, 1024, 1024}; pg8::Seq S{10, panel, 0, 0, 1};
                EpiInProj E{(bf16_t*)Pp, rs0 + panel * 256, cosb, sinb, cosd, sind, kpart + (size_t)panel * 512, pos0};
                pg8::gemm_phase<EpiInProj>(lds, g, S, E);
            }
            {
                const int tq = opaque_tid(); const int row = tq >> 1, hf = tq & 1;
                const bf16_t* cq = (const bf16_t*)(Pp + B_CQ * BUFB) + row * 256 + hf * 96; float s = 0.f;
#pragma unroll
                for (int k = 0; k < 12; ++k) { const bf16x8 v = *(const bf16x8*)(cq + 8 * k);
#pragma unroll
                    for (int e = 0; e < 8; ++e) { const float f = bf2f(v[e]); s += f * f; } }
                s += __shfl_xor(s, 1);
                const bf16_t* ck = (const bf16_t*)(Pp + B_CKV * BUFB) + row * 256 + hf * 64; float s2 = 0.f;
#pragma unroll
                for (int k = 0; k < 8; ++k) { const bf16x8 v = *(const bf16x8*)(ck + 8 * k);
#pragma unroll
                    for (int e = 0; e < 8; ++e) { const float f = bf2f(v[e]); s2 += f * f; } }
                s2 += __shfl_xor(s2, 1);
                if (hf == 0) { rsq[panel * 256 + row] = 1.0f / sqrtf(s * (1.f / 192.f) + EPS); rskv[panel * 256 + row] = 1.0f / sqrtf(s2 * (1.f / 128.f) + EPS); }
                __syncthreads();
            }
            {
                pg8::Gemm g{(const bf16_t*)(Pp + B_CQ * BUFB), (const bf16_t*)(wl + OW_UQ), 256, 256, 256}; pg8::Seq S{2, 0, 0, 0, 1};
                EpiUpQ E{(bf16_t*)(Up + U_QD), rsq + panel * 256, cosd, sind, pos0};
                pg8::gemm_phase<EpiUpQ>(lds, g, S, E);
            }
            {
                pg8::Gemm g{(const bf16_t*)(Pp + B_CKV * BUFB), (const bf16_t*)(wl + OW_UKV), 256, 128, 128}; pg8::Seq S{2, 0, 0, 0, 1};
                EpiUpKV E{(bf16_t*)(Up + U_KD), (bf16_t*)(Up + U_VD), rskv + panel * 256};
                pg8::gemm_phase<EpiUpKV>(lds, g, S, E);
            }
            for (int c = 0; c < 2; ++c) {
                constexpr int VS = 272;
                {
                    const int tq = opaque_tid(); const int t = tq >> 2, part = tq & 3;
                    const bf16_t* vp = (const bf16_t*)(Pp + B_AV * BUFB) + (128 * c + t) * 256 + part * 64;
                    bf16x8 vv[8]; float s = 0.f, s2 = 0.f;
#pragma unroll
                    for (int k = 0; k < 8; ++k) { vv[k] = *(const bf16x8*)(vp + 8 * k);
#pragma unroll
                        for (int e = 0; e < 8; ++e) { const float f = bf2f(vv[k][e]); s += f; s2 += f * f; } }
                    s += __shfl_xor(s, 1); s += __shfl_xor(s, 2); s2 += __shfl_xor(s2, 1); s2 += __shfl_xor(s2, 2);
                    const float mean = s * (1.f / 256.f), var = fmaxf(s2 * (1.f / 256.f) - mean * mean, 0.f), rstd = 1.0f / sqrtf(var + 1e-5f);
                    const float* lg = p.a_ln_g + l * 256 + part * 64; const float* lb = p.a_ln_b + l * 256 + part * 64;
#pragma unroll
                    for (int k = 0; k < 8; ++k)
#pragma unroll
                        for (int e = 0; e < 8; ++e) { const int ch = part * 64 + 8 * k + e; const float f = (bf2f(vv[k][e]) - mean) * rstd * lg[8 * k + e] + lb[8 * k + e];
                            *(LAS unsigned short*)(lds + ch * VS + t * 2) = (unsigned short)(cvtpk(f, 0.f) & 0xffffu); }
                }
                __syncthreads();
                {
                    const int tq = opaque_tid(); const int lq = tq & 63; const int g4 = wid & 3, th = wid >> 2, r = lq & 31, hh = lq >> 5;
                    const bf16_t* Wg = (const bf16_t*)(wl + OW_S) + (size_t)g4 * 128 * 128;
                    const float* bs = p.a_b_s + (l * 4 + g4) * 128;
                    bf16_t* au = (bf16_t*)(Pp + B_AU * BUFB);
#pragma unroll
                    for (int tb = 0; tb < 2; ++tb) {
                        const int t0 = 64 * th + 32 * tb;
                        f32x16 a0, a1;
#pragma unroll
                        for (int i = 0; i < 16; ++i) { a0[i] = 0.f; a1[i] = 0.f; }
                        for (int ks = 0; 16 * ks <= t0 + 31; ++ks) {
                            const bf16x8 wa = *(const bf16x8*)(Wg + (t0 + r) * 128 + 16 * ks + 8 * hh);
                            const bf16x8 b0 = *(const LAS bf16x8*)(lds + (64 * g4 + r) * VS + (16 * ks + 8 * hh) * 2);
                            const bf16x8 b1 = *(const LAS bf16x8*)(lds + (64 * g4 + 32 + r) * VS + (16 * ks + 8 * hh) * 2);
                            a0 = MFMA32(wa, b0, a0); a1 = MFMA32(wa, b1, a1);
                        }
#pragma unroll
                        for (int i = 0; i < 16; ++i) { const int t = t0 + crow(i, hh); const float bb = bs[t]; bf16_t* up = au + (128 * c + t) * 256 + 64 * g4 + r;
                            const float u0 = bf2f((short)up[0]), u1 = bf2f((short)up[32]);
                            up[0] = (bf16_t)(cvtpk(u0 * (a0[i] + bb), 0.f) & 0xffffu); up[32] = (bf16_t)(cvtpk(u1 * (a1[i] + bb), 0.f) & 0xffffu); }
                    }
                }
                __syncthreads();
            }
        }
        grid.sync();
        for (int panel = bx; panel < NPANEL; panel += G) {
            unsigned char* Pp = Pb + (size_t)panel * PSTRIDE; const int pos0 = (panel & 15) * 256;
            const float* wc = p.c_w_conv + l * 3 * 256;
            const int tqc = opaque_tid();
            for (int it = 0; it < 16; ++it) {
                const int item = it * 512 + tqc, row = item >> 5, ch = (item & 31) * 8; const int pos = pos0 + row;
                float z[3][8];
#pragma unroll
                for (int d = 0; d < 3; ++d) {
                    if (pos - d >= 0) { const int rr = row - d; const unsigned char* Pz = rr >= 0 ? Pp : Pp - PSTRIDE; const int ri = rr >= 0 ? rr : rr + 256;
                        const bf16x8 cc = *(const bf16x8*)((const bf16_t*)(Pz + B_CC * BUFB) + ri * 256 + ch), cx = *(const bf16x8*)((const bf16_t*)(Pz + B_CX * BUFB) + ri * 256 + ch);
#pragma unroll
                        for (int e = 0; e < 8; ++e) z[d][e] = bf2f(cc[e]) * bf2f(cx[e]); }
                    else {
#pragma unroll
                        for (int e = 0; e < 8; ++e) z[d][e] = 0.f; }
                }
                bf16_t* cbp = (bf16_t*)(Pp + B_CB * BUFB) + row * 256 + ch; const bf16x8 cb = *(const bf16x8*)cbp; float o[8];
#pragma unroll
                for (int e = 0; e < 8; ++e) o[e] = bf2f(cb[e]) * (wc[ch + e] * z[2][e] + wc[256 + ch + e] * z[1][e] + wc[512 + ch + e] * z[0][e]);
                u32x4 w; w.x = cvtpk(o[0], o[1]); w.y = cvtpk(o[2], o[3]); w.z = cvtpk(o[4], o[5]); w.w = cvtpk(o[6], o[7]);
                *(u32x4*)cbp = w;
            }
        }
        for (int v = bx; v < 256; v += G) {
            const int bh = v >> 2, s = v & 3, b = bh >> 2, h = bh & 3;
            for (int i = 0; i < 4; ++i) { const int qb = (i == 0) ? s : (i == 1) ? 7 - s : (i == 2) ? 8 + s : 15 - s;
                attn_unit<64, true>(b, h, qb, Pb, Ub, kpart, lds);
                attn_unit<96, false>(b, h, qb, Pb, Ub, kpart, lds); }
        }
        grid.sync();
        for (int panel = bx; panel < NPANEL; panel += G) {
            unsigned char* Pp = Pb + (size_t)panel * PSTRIDE; unsigned char* Up = Ub + (size_t)panel * USTRIDE;
            for (int pnn = 0; pnn < 4; ++pnn) {
                {
                    pg8::Gemm g{xb, (const bf16_t*)(wl + OW_G), 1024, 1024, 1024}; pg8::Seq S{4, panel, 0, pnn, 4};
                    EpiG E{Up + U_G, rs0 + panel * 256};
                    pg8::gemm_phase<EpiG>(lds, g, S, E);
                }
                {
                    pg8::Gemm g{(const bf16_t*)Pp, (const bf16_t*)(wl + OW_B), 256, 256, 256}; pg8::Seq S{4, 0, 1, pnn, 4};
                    EpiY E{Up + U_G, Up + U_M, (bf16_t*)(Up + U_MERGED), pnn};
                    pg8::gemm_phase<EpiY>(lds, g, S, E);
                }
            }
            {
                pg8::Gemm g{(const bf16_t*)(Up + U_MERGED), (const bf16_t*)(wl + OW_OUT), 1024, 1024, 1024}; pg8::Seq S{4, 0, 0, 0, 1};
                EpiF32 E{(float*)Pp, 0};
                pg8::gemm_phase<EpiF32>(lds, g, S, E);
            }
            float* xo = p.out + (size_t)panel * 256 * DM;
            norm_step((const float*)Pp, (l == 0) ? p.x + (size_t)panel * 256 * DM : xo, xo, xb + (size_t)panel * 256 * DM, rs1 + panel * 256, p.g_post_mix + l * DM, wid, lane);
            __syncthreads();
            for (int hf = 0; hf < 2; ++hf) {
                {
                    pg8::Gemm g{xb, (const bf16_t*)(wl + OW_1), 1024, 1024, 1024}; pg8::Seq S{8, panel, 0, hf * 8, 1};
                    EpiMlpIn E{(bf16_t*)Up, rs1 + panel * 256, hf * 8};
                    pg8::gemm_phase<EpiMlpIn>(lds, g, S, E);
                }
                {
                    pg8::Gemm g{(const bf16_t*)Up, (const bf16_t*)(wl + OW_2) + hf * 2048, 2048, 4096, 2048}; pg8::Seq S{4, 0, 0, 0, 1};
                    EpiF32 E{(float*)Pp, hf};
                    pg8::gemm_phase<EpiF32>(lds, g, S, E);
                }
            }
            norm_step((const float*)Pp, xo, xo, xb + (size_t)panel * 256 * DM, rs0 + panel * 256, p.g_post_mlp + l * DM, wid, lane);
            __syncthreads();
        }
    }
}

extern "C" void kernel_launch(void* const* d_in, const int* in_sizes, int n_in, void* d_out, int out_size, void* d_ws, size_t ws_size, hipStream_t stream) {
    static int grid = 0;
    if (grid == 0) {
        if (n_in != 19 || out_size != T * DM || ws_size < WS_END) { fprintf(stderr, "kernel_launch: unexpected shapes (n_in %d out %d ws %zu need %zu)\n", n_in, out_size, ws_size, (size_t)WS_END); grid = -1; return; }
        int dev = 0, cus = 0, per_cu = 0;
        hipGetDevice(&dev); hipDeviceGetAttribute(&cus, hipDeviceAttributeMultiprocessorCount, dev);
        hipFuncSetAttribute((const void*)hybrid_fwd, hipFuncAttributeMaxDynamicSharedMemorySize, LDS_BYTES);
        hipOccupancyMaxActiveBlocksPerMultiprocessor(&per_cu, (const void*)hybrid_fwd, 512, LDS_BYTES);
        if (per_cu < 1) per_cu = 1;
        (void)hipGetLastError();
        grid = cus * per_cu; if (grid > 256) grid = 256;
    }
    if (grid < 0) return;
    Params p{};
    const float** pp = (const float**)&p;
    for (int i = 0; i < 19; ++i) pp[i] = (const float*)d_in[i];
    p.out = (float*)d_out; p.ws = (unsigned char*)d_ws;
    for (int i = 0; i < 8; ++i) p.invb[i] = 1.0f / powf(500000.0f, (float)(2 * i) / 16.0f);
    for (int i = 0; i < 16; ++i) p.invd[i] = 1.0f / powf(500000.0f, (float)(2 * i) / 32.0f);
    void* args[] = {&p};
    hipError_t e = hipLaunchCooperativeKernel((const void*)hybrid_fwd, dim3(grid), dim3(512), args, LDS_BYTES, stream);
    if (e != hipSuccess) fprintf(stderr, "cooperative launch failed: %s (grid %d)\n", hipGetErrorString(e), grid);
}
```

```cpp
#include <hip/hip_runtime.h>
#include <hip/hip_cooperative_groups.h>
#include <cstdio>
#include <cstdint>
#include <cmath>
namespace cg = cooperative_groups;

#define LAS __attribute__((address_space(3)))
typedef unsigned short bf16_t;
typedef short bf16x8 __attribute__((ext_vector_type(8)));
typedef short s16x4 __attribute__((ext_vector_type(4)));
typedef float f32x4 __attribute__((ext_vector_type(4)));
typedef float f32x2 __attribute__((ext_vector_type(2)));
typedef float f32x16 __attribute__((ext_vector_type(16)));
typedef unsigned u32x4 __attribute__((ext_vector_type(4)));
typedef unsigned u32x2 __attribute__((ext_vector_type(2)));
typedef __bf16 bf16x2_t __attribute__((ext_vector_type(2)));
#define DI __device__ __forceinline__

constexpr int T = 65536, DM = 1024, SEQ = 4096, NPANEL = 256, NL = 4, INC = 6496, DFF = 4096;
constexpr float EPS = 1e-6f;
constexpr float LOG2E = 1.4426950408889634f;
constexpr float C2M = 0.125f * LOG2E;
constexpr float C2D = 0.10206207261596575f * LOG2E;

constexpr size_t SZ_WIN = 2560ull * 1024 * 2, SZ_WG = 4096ull * 1024 * 2, SZ_WB = 4096ull * 256 * 2, SZ_WOUT = 1024ull * 1024 * 2,
                 SZ_W1 = 4096ull * 1024 * 2, SZ_W2 = 1024ull * 4096 * 2, SZ_WUQ = 512ull * 256 * 2, SZ_WUKV = 512ull * 128 * 2, SZ_WS = 4ull * 128 * 128 * 2;
constexpr size_t OW_IN = 0, OW_G = OW_IN + SZ_WIN, OW_B = OW_G + SZ_WG, OW_OUT = OW_B + SZ_WB, OW_1 = OW_OUT + SZ_WOUT, OW_2 = OW_1 + SZ_W1,
                 OW_UQ = OW_2 + SZ_W2, OW_UKV = OW_UQ + SZ_WUQ, OW_S = OW_UKV + SZ_WUKV, W_LAYER = OW_S + SZ_WS;
constexpr size_t WS_W = 0;
constexpr size_t WS_TAB = WS_W + NL * W_LAYER;
constexpr size_t TB_COSB = 0, TB_SINB = 131072, TB_COSD = 262144, TB_SIND = 524288, SZ_TAB = 786432;
constexpr size_t WS_RS0 = WS_TAB + SZ_TAB, WS_RS1 = WS_RS0 + 262144, WS_RSQ = WS_RS1 + 262144, WS_RSKV = WS_RSQ + 262144;
constexpr size_t WS_KPART = WS_RSKV + 262144;
constexpr size_t WS_XB = WS_KPART + 524288;
constexpr size_t WS_P = WS_XB + (size_t)T * DM * 2;
constexpr size_t BUFB = 256ull * 256 * 2, PSTRIDE = 10 * BUFB;
constexpr size_t WS_U = WS_P + NPANEL * PSTRIDE;
constexpr size_t USTRIDE = PSTRIDE;
constexpr size_t WS_END = WS_U + NPANEL * USTRIDE;
constexpr size_t U_QD = 0, U_KD = 196608, U_VD = 327680;
constexpr size_t U_G = 0, U_M = 524288, U_MERGED = 786432;
enum { B_AU = 0, B_BQ = 1, B_CB = 2, B_CQ = 3, B_AV = 4, B_BK = 5, B_BV = 6, B_CC = 7, B_CX = 8, B_CKV = 9 };

constexpr int RING_BYTES = 131072, LDS_BYTES = 147456;

DI int opaque_tid() { int t = threadIdx.x; asm volatile("" : "+v"(t)); return t; }
DI unsigned cvtpk(float lo, float hi) { f32x2 v = {lo, hi}; bf16x2_t b = __builtin_convertvector(v, bf16x2_t); return __builtin_bit_cast(unsigned, b); }
DI float bf2f(short s) { return __uint_as_float(((unsigned)(unsigned short)s) << 16); }
DI float wave_sum(float v) {
#pragma unroll
    for (int o = 1; o < 64; o <<= 1) v += __shfl_xor(v, o);
    return v;
}
DI float gelu_tanh(float v) {
    const float z = 0.7978845608028654f * (v + 0.044715f * v * v * v);
    return v * __builtin_amdgcn_rcpf(1.f + __builtin_amdgcn_exp2f(-2.f * LOG2E * z));
}
DI float sigmoidf_(float v) { return __builtin_amdgcn_rcpf(1.f + __builtin_amdgcn_exp2f(-LOG2E * v)); }

namespace pg8 {
constexpr int BM = 256, BK = 64, HALF = 128, HTB = HALF * BK * 2;
DI int lds_byte(int r, int c) { const int st = (r >> 4) * 2 + (c >> 5), rr = r & 15, cc = c & 31, ob = rr * 64 + cc * 2; return st * 1024 + (ob ^ (((ob >> 9) & 1) << 5)); }
DI void stage_rc(int b, int& R, int& C) { const int st = b / 1024, sb = b % 1024, swz = sb ^ (((sb >> 9) & 1) << 5); R = (st >> 1) * 16 + swz / 64; C = (st & 1) * 32 + (swz % 64) / 2; }
DI int perm32(int rho) { const int n = rho >> 4, i = rho & 15; return 8 * (i >> 2) + 4 * n + (i & 3); }
struct Unit { int pm, pn; };
struct Gemm { const bf16_t* A; const bf16_t* Bt; int lda, ldb, K; };
struct Seq { int n, pm0, pms, pn0, pns;
    DI bool next(int i, Unit& u) const { if (i >= n) return false; u.pm = pm0 + i * pms; u.pn = pn0 + i * pns; return true; } };

template <class Epi>
DI void gemm_phase(LAS unsigned char* lds, const Gemm g, const Seq& S_in, const Epi& E) {
    Seq S = S_in; asm volatile("" : "+s"(S.n));
    const int tid = opaque_tid(), wid = __builtin_amdgcn_readfirstlane(tid >> 6), lane = tid & 63, wr = wid >> 2, wc = wid & 3, fr = lane & 15, fq = lane >> 4;
    int K = g.K; asm volatile("" : "+s"(K)); const int nt = K / BK;
    unsigned voffA[2], voffB[2];
#pragma unroll
    for (int i = 0; i < 2; ++i) { int R, C; stage_rc(tid * 16 + i * 8192, R, C); const int Rb = Epi::PERM ? ((R & ~31) + perm32(R & 31)) : R;
        voffA[i] = (unsigned)(R * g.lda + C) * 2u; voffB[i] = (unsigned)(Rb * g.ldb + C) * 2u; }
    const size_t kstep = (size_t)(BK * 2);
    const size_t hstepA = (size_t)HALF * g.lda * 2, hstepB = (size_t)HALF * g.ldb * 2;
    const size_t tstepA = 2 * hstepA, tstepB = 2 * hstepB;
    const unsigned ldsw = (unsigned)wid * 1024u;
    const int aoff = lds_byte(wr * 64 + fr, fq * 8), boff = lds_byte(wc * 32 + fr, fq * 8);
#define PG8_SA(b, h) (((b) * 2 + (h)) * HTB)
#define PG8_SB(b, h) ((4 + (b) * 2 + (h)) * HTB)
#define PG8_STAGE(bufoff, gbase, voff) do { _Pragma("unroll") for (int _i = 0; _i < 2; ++_i) \
        __builtin_amdgcn_global_load_lds((const unsigned*)((const char*)(gbase) + (voff)[_i]), (LAS unsigned*)(lds + (bufoff) + ldsw + _i * 8192), 16, 0, 0); } while (0)
#define PG8_LDA(dst, b, h) do { _Pragma("unroll") for (int m = 0; m < 4; ++m) _Pragma("unroll") for (int k = 0; k < 2; ++k) dst[m][k] = *(const LAS bf16x8*)(lds + PG8_SA(b, h) + aoff + m * 2048 + k * 1024); } while (0)
#define PG8_LDB(dst, b, h) do { _Pragma("unroll") for (int n = 0; n < 2; ++n) _Pragma("unroll") for (int k = 0; k < 2; ++k) dst[n][k] = *(const LAS bf16x8*)(lds + PG8_SB(b, h) + boff + n * 2048 + k * 1024); } while (0)
#define PG8_MMA(ai, bj, At, Bt) do { __builtin_amdgcn_s_setprio(1); _Pragma("unroll") for (int m = 0; m < 4; ++m) _Pragma("unroll") for (int n = 0; n < 2; ++n) _Pragma("unroll") for (int k = 0; k < 2; ++k) \
        acc[ai][bj][m][n] = __builtin_amdgcn_mfma_f32_16x16x32_bf16(Bt[n][k], At[m][k], acc[ai][bj][m][n], 0, 0, 0); __builtin_amdgcn_s_setprio(0); } while (0)
#define PG8_WAIT_V(n) asm volatile("s_waitcnt vmcnt(" #n ")" ::: "memory")
#define PG8_WAIT_L(n) asm volatile("s_waitcnt lgkmcnt(" #n ")" ::: "memory")
#define PG8_BAR __builtin_amdgcn_s_barrier()
#define PG8_SCHED __builtin_amdgcn_sched_barrier(0)
    Unit cur, nxt; int ui = 0;
    if (!S.next(0, cur)) return;
    f32x4 acc[2][2][4][2];
#pragma unroll
    for (int a = 0; a < 2; ++a)
#pragma unroll
        for (int b = 0; b < 2; ++b)
#pragma unroll
            for (int m = 0; m < 4; ++m)
#pragma unroll
                for (int n = 0; n < 2; ++n) acc[a][b][m][n] = (f32x4){0.f, 0.f, 0.f, 0.f};
    bf16x8 At[4][2], B0[2][2], B1[2][2];
    const char* cA = (const char*)g.A + (size_t)cur.pm * tstepA; const char* cB = (const char*)g.Bt + (size_t)cur.pn * tstepB;
    PG8_STAGE(PG8_SB(0, 0), cB, voffB); PG8_STAGE(PG8_SB(0, 1), cB + hstepB, voffB); PG8_STAGE(PG8_SA(0, 0), cA, voffA); PG8_STAGE(PG8_SA(0, 1), cA + hstepA, voffA);
    if (wr == 1) PG8_BAR;
    PG8_WAIT_V(2); PG8_BAR;
    PG8_STAGE(PG8_SB(1, 0), cB + kstep, voffB); PG8_STAGE(PG8_SA(1, 0), cA + kstep, voffA); PG8_STAGE(PG8_SB(1, 1), cB + hstepB + kstep, voffB);
    PG8_WAIT_V(6); PG8_BAR;
    for (;;) {
        const bool has_next = S.next(ui + 1, nxt);
        const char* nA = has_next ? (const char*)g.A + (size_t)nxt.pm * tstepA : cA; const char* nB = has_next ? (const char*)g.Bt + (size_t)nxt.pn * tstepB : cB;
#pragma nounroll
        for (int t = 0; t < nt; t += 2) {
            const bool last = (t == nt - 2);
            const char* a1 = cA + (size_t)(t + 1) * kstep;
            const char* a2 = last ? nA : cA + (size_t)(t + 2) * kstep; const char* b2 = last ? nB : cB + (size_t)(t + 2) * kstep;
            const char* a3 = a2 + kstep; const char* b3 = b2 + kstep;
            PG8_LDB(B0, 0, 0); PG8_LDB(B1, 0, 1); PG8_SCHED; PG8_LDA(At, 0, 0); PG8_STAGE(PG8_SA(1, 1), a1 + hstepA, voffA);
            PG8_WAIT_V(8); PG8_WAIT_L(0); PG8_BAR; PG8_MMA(0, 0, At, B0); PG8_MMA(0, 1, At, B1); PG8_BAR; PG8_SCHED;
            PG8_LDA(At, 0, 1); PG8_STAGE(PG8_SB(0, 0), b2, voffB); PG8_STAGE(PG8_SB(0, 1), b2 + hstepB, voffB); PG8_STAGE(PG8_SA(0, 0), a2, voffA);
            PG8_WAIT_V(8); PG8_WAIT_L(0); PG8_BAR; PG8_MMA(1, 0, At, B0); PG8_MMA(1, 1, At, B1); PG8_BAR; PG8_SCHED;
            PG8_LDB(B0, 1, 0); PG8_LDB(B1, 1, 1); PG8_SCHED; PG8_LDA(At, 1, 0); PG8_STAGE(PG8_SA(0, 1), a2 + hstepA, voffA);
            PG8_WAIT_V(8); PG8_WAIT_L(0); PG8_BAR; PG8_MMA(0, 0, At, B0); PG8_MMA(0, 1, At, B1); PG8_BAR; PG8_SCHED;
            PG8_LDA(At, 1, 1); PG8_STAGE(PG8_SB(1, 0), b3, voffB); PG8_STAGE(PG8_SB(1, 1), b3 + hstepB, voffB); PG8_STAGE(PG8_SA(1, 0), a3, voffA);
            PG8_WAIT_V(8); PG8_WAIT_L(0); PG8_BAR; PG8_MMA(1, 0, At, B0); PG8_MMA(1, 1, At, B1); PG8_BAR; PG8_SCHED;
        }
        if (wr == 0) PG8_BAR;
        E(acc, cur, wr, wc, fr, fq);
        if (!has_next) break;
#pragma unroll
        for (int a = 0; a < 2; ++a)
#pragma unroll
            for (int b = 0; b < 2; ++b)
#pragma unroll
                for (int m = 0; m < 4; ++m)
#pragma unroll
                    for (int n = 0; n < 2; ++n) acc[a][b][m][n] = (f32x4){0.f, 0.f, 0.f, 0.f};
        cur = nxt; cA = nA; cB = nB; ++ui;
        if (wr == 1) PG8_BAR;
    }
    PG8_WAIT_V(0);
    PG8_BAR;
#undef PG8_SA
#undef PG8_SB
#undef PG8_STAGE
#undef PG8_LDA
#undef PG8_LDB
#undef PG8_MMA
#undef PG8_WAIT_V
#undef PG8_WAIT_L
#undef PG8_BAR
#undef PG8_SCHED
}
}
using pg8::Unit;
typedef f32x4 Acc[2][2][4][2];

struct EpiInProj {
    static constexpr bool PERM = true;
    bf16_t* Pp; const float* rs; const float* cosb; const float* sinb; const float* cosd; const float* sind; float* kpart; int pos0;
    DI void operator()(const Acc& acc, const Unit& u, int wr, int wc, int fr, int fq) const {
        asm volatile("" : "+v"(fr), "+v"(fq));
        const int tile = u.pn; bf16_t* dst = Pp + (size_t)tile * 65536;
        const bool act = (tile == B_AU) || (tile == B_AV);
        const bool rope16 = ((tile == B_BQ) || (tile == B_BK)) && ((wc & 1) == 0);
        const float qs = (tile == B_BQ) ? C2M : 1.f;
        float csum[2][8];
#pragma unroll
        for (int bj = 0; bj < 2; ++bj)
#pragma unroll
            for (int e = 0; e < 8; ++e) csum[bj][e] = 0.f;
#pragma unroll
        for (int ai = 0; ai < 2; ++ai)
#pragma unroll
            for (int m = 0; m < 4; ++m) {
                const int row = ai * 128 + wr * 64 + m * 16 + fr; const float r = rs[row] * qs; const int pos = pos0 + row;
#pragma unroll
                for (int bj = 0; bj < 2; ++bj) {
                    const int c0 = bj * 128 + wc * 32 + fq * 8;
                    float v[8];
#pragma unroll
                    for (int e = 0; e < 8; ++e) v[e] = acc[ai][bj][m][e >> 2][e & 3] * r;
                    if (act) {
#pragma unroll
                        for (int e = 0; e < 8; ++e) v[e] = gelu_tanh(v[e]);
                    }
                    if (rope16) {
                        const f32x4 ca = *(const f32x4*)(cosb + pos * 8), cb2 = *(const f32x4*)(cosb + pos * 8 + 4);
                        const f32x4 sa = *(const f32x4*)(sinb + pos * 8), sb2 = *(const f32x4*)(sinb + pos * 8 + 4);
#pragma unroll
                        for (int e = 0; e < 8; ++e) { const float o = __shfl_xor(v[e], 16); const float c = e < 4 ? ca[e & 3] : cb2[e & 3], s = e < 4 ? sa[e & 3] : sb2[e & 3];
                            const float rot = (fq == 0) ? (v[e] * c - o * s) : (v[e] * c + o * s); if (fq < 2) v[e] = rot; }
                    }
                    if (tile == B_CKV && bj == 1 && wc == 0) {
                        const int ib = 8 * (fq & 1);
                        const f32x4 ca = *(const f32x4*)(cosd + pos * 16 + ib), cb2 = *(const f32x4*)(cosd + pos * 16 + ib + 4);
                        const f32x4 sa = *(const f32x4*)(sind + pos * 16 + ib), sb2 = *(const f32x4*)(sind + pos * 16 + ib + 4);
#pragma unroll
                        for (int e = 0; e < 8; ++e) { const float o = __shfl_xor(v[e], 32); const float c = e < 4 ? ca[e & 3] : cb2[e & 3], s = e < 4 ? sa[e & 3] : sb2[e & 3];
                            v[e] = (fq < 2) ? (v[e] * c - o * s) : (v[e] * c + o * s); }
                    }
                    if (tile == B_BK) {
#pragma unroll
                        for (int e = 0; e < 8; ++e) csum[bj][e] += v[e];
                    }
                    u32x4 w; w.x = cvtpk(v[0], v[1]); w.y = cvtpk(v[2], v[3]); w.z = cvtpk(v[4], v[5]); w.w = cvtpk(v[6], v[7]);
                    *(u32x4*)(dst + row * 256 + c0) = w;
                }
                asm volatile("" ::: "memory");
            }
        if (tile == B_BK) {
#pragma unroll
            for (int bj = 0; bj < 2; ++bj)
#pragma unroll
                for (int e = 0; e < 8; ++e) { float s = csum[bj][e]; s += __shfl_xor(s, 1); s += __shfl_xor(s, 2); s += __shfl_xor(s, 4); s += __shfl_xor(s, 8);
                    if (fr == 0) kpart[wr * 256 + bj * 128 + wc * 32 + fq * 8 + e] = s; }
        }
    }
};
struct EpiUpQ {
    static constexpr bool PERM = true;
    bf16_t* Qp; const float* rsq; const float* cosd; const float* sind; int pos0;
    DI void operator()(const Acc& acc, const Unit& u, int wr, int wc, int fr, int fq) const {
        asm volatile("" : "+v"(fr), "+v"(fq));
        const int tile = u.pn;
#pragma unroll
        for (int ai = 0; ai < 2; ++ai)
#pragma unroll
            for (int m = 0; m < 4; ++m) {
                const int row = ai * 128 + wr * 64 + m * 16 + fr; const float r = rsq[row] * C2D; const int pos = pos0 + row;
#pragma unroll
                for (int bj = 0; bj < 2; ++bj) {
                    float v[8];
#pragma unroll
                    for (int e = 0; e < 8; ++e) v[e] = acc[ai][bj][m][e >> 2][e & 3] * r;
                    if (tile == 0) {
                        const int c0 = bj * 128 + wc * 32 + fq * 8, head = c0 >> 6, e0 = c0 & 63;
                        u32x4 w; w.x = cvtpk(v[0], v[1]); w.y = cvtpk(v[2], v[3]); w.z = cvtpk(v[4], v[5]); w.w = cvtpk(v[6], v[7]);
                        *(u32x4*)(Qp + row * 384 + head * 96 + e0) = w;
                    } else if (bj == 0) {
                        const int ib = 8 * (fq & 1);
                        const f32x4 ca = *(const f32x4*)(cosd + pos * 16 + ib), cb2 = *(const f32x4*)(cosd + pos * 16 + ib + 4);
                        const f32x4 sa = *(const f32x4*)(sind + pos * 16 + ib), sb2 = *(const f32x4*)(sind + pos * 16 + ib + 4);
#pragma unroll
                        for (int e = 0; e < 8; ++e) { const float o = __shfl_xor(v[e], 32); const float c = e < 4 ? ca[e & 3] : cb2[e & 3], s = e < 4 ? sa[e & 3] : sb2[e & 3];
                            v[e] = (fq < 2) ? (v[e] * c - o * s) : (v[e] * c + o * s); }
                        u32x4 w; w.x = cvtpk(v[0], v[1]); w.y = cvtpk(v[2], v[3]); w.z = cvtpk(v[4], v[5]); w.w = cvtpk(v[6], v[7]);
                        *(u32x4*)(Qp + row * 384 + wc * 96 + 64 + fq * 8) = w;
                    }
                }
                asm volatile("" ::: "memory");
            }
    }
};
struct EpiUpKV {
    static constexpr bool PERM = true;
    bf16_t* Kp; bf16_t* Vp; const float* rskv;
    DI void operator()(const Acc& acc, const Unit& u, int wr, int wc, int fr, int fq) const {
        asm volatile("" : "+v"(fr), "+v"(fq));
        bf16_t* dst = u.pn == 0 ? Kp : Vp;
#pragma unroll
        for (int ai = 0; ai < 2; ++ai)
#pragma unroll
            for (int m = 0; m < 4; ++m) {
                const int row = ai * 128 + wr * 64 + m * 16 + fr; const float r = rskv[row];
#pragma unroll
                for (int bj = 0; bj < 2; ++bj) {
                    const int c0 = bj * 128 + wc * 32 + fq * 8; float v[8];
#pragma unroll
                    for (int e = 0; e < 8; ++e) v[e] = acc[ai][bj][m][e >> 2][e & 3] * r;
                    u32x4 w; w.x = cvtpk(v[0], v[1]); w.y = cvtpk(v[2], v[3]); w.z = cvtpk(v[4], v[5]); w.w = cvtpk(v[6], v[7]);
                    *(u32x4*)(dst + row * 256 + c0) = w;
                }
                asm volatile("" ::: "memory");
            }
    }
};
struct EpiG {
    static constexpr bool PERM = true;
    unsigned char* Gs; const float* rs;
    DI void operator()(const Acc& acc, const Unit& u, int wr, int wc, int fr, int fq) const {
        asm volatile("" : "+v"(fr), "+v"(fq));
        const int br = u.pn >> 2; u32x4* g = (u32x4*)(Gs + (size_t)br * 131072) + opaque_tid();
#pragma unroll
        for (int ai = 0; ai < 2; ++ai)
#pragma unroll
            for (int m = 0; m < 4; ++m) {
                const int row = ai * 128 + wr * 64 + m * 16 + fr; const float r = rs[row];
#pragma unroll
                for (int bj = 0; bj < 2; ++bj) {
                    float v[8];
#pragma unroll
                    for (int e = 0; e < 8; ++e) v[e] = sigmoidf_(acc[ai][bj][m][e >> 2][e & 3] * r);
                    u32x4 w; w.x = cvtpk(v[0], v[1]); w.y = cvtpk(v[2], v[3]); w.z = cvtpk(v[4], v[5]); w.w = cvtpk(v[6], v[7]);
                    g[((ai * 2 + bj) * 4 + m) * 512] = w;
                }
                asm volatile("" ::: "memory");
            }
    }
};
struct EpiY {
    static constexpr bool PERM = true;
    unsigned char* Gs; unsigned char* Ms; bf16_t* merged; int pnn;
    DI void operator()(const Acc& acc, const Unit& u, int wr, int wc, int fr, int fq) const {
        asm volatile("" : "+v"(fr), "+v"(fq));
        const int br = u.pm; const int tq = opaque_tid(); const u32x4* g = (const u32x4*)(Gs + (size_t)br * 131072) + tq; f32x4* ms = (f32x4*)Ms + tq;
#pragma unroll
        for (int ai = 0; ai < 2; ++ai)
#pragma unroll
            for (int m = 0; m < 4; ++m) {
                const int row = ai * 128 + wr * 64 + m * 16 + fr;
#pragma unroll
                for (int bj = 0; bj < 2; ++bj) {
                    const int k = (ai * 2 + bj) * 4 + m; const u32x4 gw = g[k * 512];
                    float gt[8]; gt[0] = __uint_as_float(gw.x << 16); gt[1] = __uint_as_float(gw.x & 0xffff0000u); gt[2] = __uint_as_float(gw.y << 16); gt[3] = __uint_as_float(gw.y & 0xffff0000u);
                    gt[4] = __uint_as_float(gw.z << 16); gt[5] = __uint_as_float(gw.z & 0xffff0000u); gt[6] = __uint_as_float(gw.w << 16); gt[7] = __uint_as_float(gw.w & 0xffff0000u);
                    f32x4 v0, v1;
#pragma unroll
                    for (int e = 0; e < 4; ++e) { v0[e] = acc[ai][bj][m][0][e] * gt[e]; v1[e] = acc[ai][bj][m][1][e] * gt[4 + e]; }
                    if (br > 0) { v0 += ms[(2 * k) * 512]; v1 += ms[(2 * k + 1) * 512]; }
                    if (br < 3) { ms[(2 * k) * 512] = v0; ms[(2 * k + 1) * 512] = v1; }
                    else { const int c0 = pnn * 256 + bj * 128 + wc * 32 + fq * 8;
                        u32x4 w; w.x = cvtpk(v0[0], v0[1]); w.y = cvtpk(v0[2], v0[3]); w.z = cvtpk(v1[0], v1[1]); w.w = cvtpk(v1[2], v1[3]);
                        *(u32x4*)(merged + row * 1024 + c0) = w; }
                }
                asm volatile("" ::: "memory");
            }
    }
};
struct EpiF32 {
    static constexpr bool PERM = false;
    float* Y; int accum;
    DI void operator()(const Acc& acc, const Unit& u, int wr, int wc, int fr, int fq) const {
        asm volatile("" : "+v"(fr), "+v"(fq));
#pragma unroll
        for (int ai = 0; ai < 2; ++ai)
#pragma unroll
            for (int m = 0; m < 4; ++m) {
                const int row = ai * 128 + wr * 64 + m * 16 + fr;
#pragma unroll
                for (int bj = 0; bj < 2; ++bj)
#pragma unroll
                    for (int n = 0; n < 2; ++n) { f32x4* p = (f32x4*)(Y + row * 1024 + u.pn * 256 + bj * 128 + wc * 32 + n * 16 + fq * 4);
                        f32x4 v = acc[ai][bj][m][n]; if (accum) v += *p; *p = v; }
                asm volatile("" ::: "memory");
            }
    }
};
struct EpiMlpIn {
    static constexpr bool PERM = true;
    bf16_t* Uo; const float* rs; int pn_base;
    DI void operator()(const Acc& acc, const Unit& u, int wr, int wc, int fr, int fq) const {
        asm volatile("" : "+v"(fr), "+v"(fq));
        const int ct = (u.pn - pn_base) * 256;
#pragma unroll
        for (int ai = 0; ai < 2; ++ai)
#pragma unroll
            for (int m = 0; m < 4; ++m) {
                const int row = ai * 128 + wr * 64 + m * 16 + fr; const float r = rs[row];
#pragma unroll
                for (int bj = 0; bj < 2; ++bj) {
                    const int c0 = ct + bj * 128 + wc * 32 + fq * 8; float v[8];
#pragma unroll
                    for (int e = 0; e < 8; ++e) { const float t = fmaxf(acc[ai][bj][m][e >> 2][e & 3] * r, 0.f); v[e] = t * t; }
                    u32x4 w; w.x = cvtpk(v[0], v[1]); w.y = cvtpk(v[2], v[3]); w.z = cvtpk(v[4], v[5]); w.w = cvtpk(v[6], v[7]);
                    *(u32x4*)(Uo + row * 2048 + c0) = w;
                }
                asm volatile("" ::: "memory");
            }
    }
};

DI int crow(int r, int hi) { return (r & 3) + 8 * (r >> 2) + 4 * hi; }
#define MFMA32(a, b, c) __builtin_amdgcn_mfma_f32_32x32x16_bf16((a), (b), (c), 0, 0, 0)
template <int DQK, bool MOBA>
DI void attn_unit(int b, int h, int qb, unsigned char* P, unsigned char* U, const float* kpart, LAS unsigned char* lds, int obuf) {
    constexpr int ND0 = DQK / 16, KSTR = DQK * 2 + 16, VSTR = 144;
    constexpr int L_K = 0, L_V = 13312, L_KM = 22528;
    constexpr float NEG = -1e30f;
    const int tid = opaque_tid(), lane = tid & 63, wid = __builtin_amdgcn_readfirstlane(tid >> 6), r = lane & 31, hh = lane >> 5;
    const int panel_q = b * 16 + qb;
    unsigned char* Pq = P + (size_t)panel_q * PSTRIDE; unsigned char* Uq = U + (size_t)panel_q * USTRIDE;
    const bf16_t* qrow = MOBA ? (const bf16_t*)(Pq + B_BQ * BUFB) + (32 * wid + r) * 256 + h * 64 : (const bf16_t*)(Uq + U_QD) + (32 * wid + r) * 384 + h * 96;
    bf16x8 qf[ND0];
#pragma unroll
    for (int d0 = 0; d0 < ND0; ++d0) qf[d0] = *(const bf16x8*)(qrow + 16 * d0 + 8 * hh);
    unsigned mask = 0xffffffffu;
    if (MOBA) {
        LAS float* km = (LAS float*)(lds + L_KM);
        __syncthreads();
        for (int idx = tid; idx < qb * 64; idx += 512) { const int n = idx >> 6, d = idx & 63; const float* kp = kpart + (size_t)(b * 16 + n) * 512 + h * 64 + d; km[idx] = (kp[0] + kp[256]) * (1.f / 256.f); }
        __syncthreads();
        if (qb <= 3) mask = (1u << qb) - 1u;
        else {
            float qv[ND0 * 8];
#pragma unroll
            for (int d0 = 0; d0 < ND0; ++d0)
#pragma unroll
                for (int j = 0; j < 8; ++j) qv[d0 * 8 + j] = bf2f(qf[d0][j]);
            float v1 = -INFINITY, v2 = -INFINITY, v3 = -INFINITY; int i1 = -1, i2 = -1, i3 = -1;
            for (int n = 0; n < qb; ++n) {
                float g = 0.f;
#pragma unroll
                for (int d0 = 0; d0 < ND0; ++d0)
#pragma unroll
                    for (int j = 0; j < 8; ++j) g += qv[d0 * 8 + j] * km[n * 64 + 16 * d0 + 8 * hh + j];
                g += __shfl_xor(g, 32);
                if (g > v1) { v3 = v2; i3 = i2; v2 = v1; i2 = i1; v1 = g; i1 = n; }
                else if (g > v2) { v3 = v2; i3 = i2; v2 = g; i2 = n; }
                else if (g > v3) { v3 = g; i3 = n; }
            }
            mask = (1u << i1) | (1u << i2) | (1u << i3);
        }
    }
    const int NT = 4 * (qb + 1);
    const int lkey = tid >> 3, lch = tid & 7;
    u32x4 kreg, vreg, kreg2 = (u32x4){0u, 0u, 0u, 0u};
#define ATT_LOAD(kt) do { const int kp_ = b * 16 + ((kt) >> 2), r0_ = 64 * ((kt) & 3); \
        const unsigned char* Pk_ = P + (size_t)kp_ * PSTRIDE; const unsigned char* Uk_ = U + (size_t)kp_ * USTRIDE; \
        const bf16_t* ks_ = MOBA ? (const bf16_t*)(Pk_ + B_BK * BUFB) : (const bf16_t*)(Uk_ + U_KD); \
        const bf16_t* vs_ = MOBA ? (const bf16_t*)(Pk_ + B_BV * BUFB) : (const bf16_t*)(Uk_ + U_VD); \
        kreg = *(const u32x4*)(ks_ + (r0_ + lkey) * 256 + h * 64 + 8 * lch); \
        vreg = *(const u32x4*)(vs_ + (r0_ + lkey) * 256 + h * 64 + 8 * lch); \
        if (!MOBA && tid < 256) kreg2 = *(const u32x4*)((const bf16_t*)(Pk_ + B_CKV * BUFB) + (r0_ + (tid >> 2)) * 256 + 128 + 8 * (tid & 3)); } while (0)
    float mrun = NEG, lrun = 0.f;
    f32x16 o0, o1;
#pragma unroll
    for (int i = 0; i < 16; ++i) { o0[i] = 0.f; o1[i] = 0.f; }
    ATT_LOAD(0);
    for (int kt = 0; kt < NT; ++kt) {
        __syncthreads();
        *(LAS u32x4*)(lds + L_K + lkey * KSTR + lch * 16) = kreg;
        if (!MOBA && tid < 256) *(LAS u32x4*)(lds + L_K + (tid >> 2) * KSTR + 128 + (tid & 3) * 16) = kreg2;
        {
            LAS unsigned short* vt = (LAS unsigned short*)(lds + L_V + (8 * lch) * VSTR + lkey * 2);
            vt[0 * (VSTR / 2)] = (unsigned short)(vreg.x & 0xffffu); vt[1 * (VSTR / 2)] = (unsigned short)(vreg.x >> 16);
            vt[2 * (VSTR / 2)] = (unsigned short)(vreg.y & 0xffffu); vt[3 * (VSTR / 2)] = (unsigned short)(vreg.y >> 16);
            vt[4 * (VSTR / 2)] = (unsigned short)(vreg.z & 0xffffu); vt[5 * (VSTR / 2)] = (unsigned short)(vreg.z >> 16);
            vt[6 * (VSTR / 2)] = (unsigned short)(vreg.w & 0xffffu); vt[7 * (VSTR / 2)] = (unsigned short)(vreg.w >> 16);
        }
        __syncthreads();
        if (kt + 1 < NT) ATT_LOAD(kt + 1);
        const int nblk = kt >> 2; const bool diag = (nblk == qb); const int kr0 = 64 * (kt & 3);
        if (diag && kr0 > 32 * wid + 31) continue;
        bool lane_sel = true;
        if (MOBA && !diag) { lane_sel = ((mask >> nblk) & 1u) != 0u; if (!__any(lane_sel)) continue; }
        f32x16 p0, p1;
#pragma unroll
        for (int i = 0; i < 16; ++i) { p0[i] = 0.f; p1[i] = 0.f; }
#pragma unroll
        for (int d0 = 0; d0 < ND0; ++d0) {
            const bf16x8 a0 = *(const LAS bf16x8*)(lds + L_K + r * KSTR + (16 * d0 + 8 * hh) * 2);
            const bf16x8 a1 = *(const LAS bf16x8*)(lds + L_K + (32 + r) * KSTR + (16 * d0 + 8 * hh) * 2);
            p0 = MFMA32(a0, qf[d0], p0); p1 = MFMA32(a1, qf[d0], p1);
        }
        if (diag) { const int qr = 32 * wid + r;
#pragma unroll
            for (int i = 0; i < 16; ++i) { const int kk = kr0 + crow(i, hh); if (kk > qr) p0[i] = NEG; if (kk + 32 > qr) p1[i] = NEG; } }
        if (MOBA && !diag && !lane_sel) {
#pragma unroll
            for (int i = 0; i < 16; ++i) { p0[i] = NEG; p1[i] = NEG; } }
        float mx = fmaxf(p0[0], p1[0]);
#pragma unroll
        for (int i = 1; i < 16; ++i) mx = fmaxf(mx, fmaxf(p0[i], p1[i]));
        mx = fmaxf(mx, __shfl_xor(mx, 32));
        const float mnew = fmaxf(mrun, mx), alpha = __builtin_amdgcn_exp2f(mrun - mnew); mrun = mnew;
        float ps = 0.f;
#pragma unroll
        for (int i = 0; i < 16; ++i) { p0[i] = __builtin_amdgcn_exp2f(p0[i] - mnew); p1[i] = __builtin_amdgcn_exp2f(p1[i] - mnew); ps += p0[i] + p1[i]; }
        lrun = lrun * alpha + ps;
#pragma unroll
        for (int i = 0; i < 16; ++i) { o0[i] *= alpha; o1[i] *= alpha; }
#pragma unroll
        for (int kh = 0; kh < 2; ++kh)
#pragma unroll
            for (int s = 0; s < 2; ++s) {
                u32x4 pw;
                if (kh == 0) { pw.x = cvtpk(p0[8 * s], p0[8 * s + 1]); pw.y = cvtpk(p0[8 * s + 2], p0[8 * s + 3]); pw.z = cvtpk(p0[8 * s + 4], p0[8 * s + 5]); pw.w = cvtpk(p0[8 * s + 6], p0[8 * s + 7]); }
                else { pw.x = cvtpk(p1[8 * s], p1[8 * s + 1]); pw.y = cvtpk(p1[8 * s + 2], p1[8 * s + 3]); pw.z = cvtpk(p1[8 * s + 4], p1[8 * s + 5]); pw.w = cvtpk(p1[8 * s + 6], p1[8 * s + 7]); }
                const bf16x8 pf = __builtin_bit_cast(bf16x8, pw);
                const int kb = (32 * kh + 16 * s + 4 * hh) * 2;
                {   const u32x2 lo = *(const LAS u32x2*)(lds + L_V + r * VSTR + kb), hi = *(const LAS u32x2*)(lds + L_V + r * VSTR + kb + 16);
                    const u32x4 vv = (u32x4){lo.x, lo.y, hi.x, hi.y}; o0 = MFMA32(__builtin_bit_cast(bf16x8, vv), pf, o0); }
                {   const u32x2 lo = *(const LAS u32x2*)(lds + L_V + (32 + r) * VSTR + kb), hi = *(const LAS u32x2*)(lds + L_V + (32 + r) * VSTR + kb + 16);
                    const u32x4 vv = (u32x4){lo.x, lo.y, hi.x, hi.y}; o1 = MFMA32(__builtin_bit_cast(bf16x8, vv), pf, o1); }
            }
    }
#undef ATT_LOAD
    lrun += __shfl_xor(lrun, 32);
    const float rl = 1.f / lrun;
    bf16_t* orow = (bf16_t*)(Pq + (size_t)obuf * BUFB) + (32 * wid + r) * 256 + h * 64;
#pragma unroll
    for (int g4 = 0; g4 < 4; ++g4) {
        u32x2 w0, w1;
        w0.x = cvtpk(o0[4 * g4] * rl, o0[4 * g4 + 1] * rl); w0.y = cvtpk(o0[4 * g4 + 2] * rl, o0[4 * g4 + 3] * rl);
        w1.x = cvtpk(o1[4 * g4] * rl, o1[4 * g4 + 1] * rl); w1.y = cvtpk(o1[4 * g4 + 2] * rl, o1[4 * g4 + 3] * rl);
        *(u32x2*)(orow + 8 * g4 + 4 * hh) = w0; *(u32x2*)(orow + 32 + 8 * g4 + 4 * hh) = w1;
    }
}

struct Params {
    const float* x; const float* g_pre_mix; const float* w_in; const float* a_ln_g; const float* a_ln_b; const float* a_w_s; const float* a_b_s; const float* c_w_conv;
    const float* d_q_norm_g; const float* d_w_uq; const float* d_kv_norm_g; const float* d_w_ukv; const float* w_branch; const float* w_out; const float* g_post_mix;
    const float* g_pre_mlp; const float* w_mlp_in; const float* w_mlp_out; const float* g_post_mlp;
    float* out; unsigned char* ws;
    float invb[8]; float invd[16];
};

DI void norm_step(const float* y, const float* xsrc, float* xdst, bf16_t* xb, float* rs_out, const float* gain, int wid, int lane_) {
    int lane = lane_; asm volatile("" : "+v"(lane));
    f32x4 gv[4];
#pragma unroll
    for (int j = 0; j < 4; ++j) gv[j] = *(const f32x4*)(gain + 4 * lane + 256 * j);
    for (int rr = 0; rr < 32; rr += 4) {
        f32x4 yv[4][4], xv[4][4];
#pragma unroll
        for (int q = 0; q < 4; ++q)
#pragma unroll
            for (int j = 0; j < 4; ++j) { const int row = wid * 32 + rr + q; yv[q][j] = *(const f32x4*)(y + row * 1024 + 4 * lane + 256 * j); xv[q][j] = *(const f32x4*)(xsrc + (size_t)row * 1024 + 4 * lane + 256 * j); }
#pragma unroll
        for (int q = 0; q < 4; ++q) {
            const int row = wid * 32 + rr + q; float ss = 0.f;
#pragma unroll
            for (int j = 0; j < 4; ++j) ss += yv[q][j].x * yv[q][j].x + yv[q][j].y * yv[q][j].y + yv[q][j].z * yv[q][j].z + yv[q][j].w * yv[q][j].w;
            const float ry = 1.0f / sqrtf(wave_sum(ss) * (1.f / 1024.f) + EPS); float s2 = 0.f;
#pragma unroll
            for (int j = 0; j < 4; ++j) { const f32x4 xn = xv[q][j] + yv[q][j] * ry * gv[j];
                *(f32x4*)(xdst + (size_t)row * 1024 + 4 * lane + 256 * j) = xn; s2 += xn.x * xn.x + xn.y * xn.y + xn.z * xn.z + xn.w * xn.w;
                u32x2 w; w.x = cvtpk(xn.x, xn.y); w.y = cvtpk(xn.z, xn.w); *(u32x2*)(xb + (size_t)row * 1024 + 4 * lane + 256 * j) = w; }
            s2 = wave_sum(s2);
            if (lane == 0) rs_out[row] = 1.0f / sqrtf(s2 * (1.f / 1024.f) + EPS);
        }
    }
}
DI void prep_panel(const float* xsrc, bf16_t* xb, float* rs_out, int wid, int lane_) {
    int lane = lane_; asm volatile("" : "+v"(lane));
    for (int rr = 0; rr < 32; rr += 4) {
        f32x4 xv[4][4];
#pragma unroll
        for (int q = 0; q < 4; ++q)
#pragma unroll
            for (int j = 0; j < 4; ++j) xv[q][j] = *(const f32x4*)(xsrc + (size_t)(wid * 32 + rr + q) * 1024 + 4 * lane + 256 * j);
#pragma unroll
        for (int q = 0; q < 4; ++q) {
            const int row = wid * 32 + rr + q; float s2 = 0.f;
#pragma unroll
            for (int j = 0; j < 4; ++j) { const f32x4 xn = xv[q][j]; s2 += xn.x * xn.x + xn.y * xn.y + xn.z * xn.z + xn.w * xn.w;
                u32x2 w; w.x = cvtpk(xn.x, xn.y); w.y = cvtpk(xn.z, xn.w); *(u32x2*)(xb + (size_t)row * 1024 + 4 * lane + 256 * j) = w; }
            s2 = wave_sum(s2);
            if (lane == 0) rs_out[row] = 1.0f / sqrtf(s2 * (1.f / 1024.f) + EPS);
        }
    }
}
struct TJob { const float* src; int src_ld, src_col0, nvalid, ksrc; bf16_t* dst; int ndst, kdst; const float* g; };
DI TJob get_job(const Params& p, int l, int j) {
    unsigned char* wl = p.ws + WS_W + (size_t)l * W_LAYER; TJob t;
    const float* win = p.w_in + (size_t)l * DM * INC;
    if (j < 10) {
        const int st[10] = {0, 512, 1280, 2048, 256, 768, 1024, 1536, 1792, 2240}; const int nv[10] = {256, 256, 256, 192, 256, 256, 256, 256, 256, 160};
        int s0 = 0, n0 = 0;
#pragma unroll
        for (int q = 0; q < 10; ++q) if (q == j) { s0 = st[q]; n0 = nv[q]; }
        t = TJob{win, INC, s0, n0, 1024, (bf16_t*)(wl + OW_IN) + (size_t)j * 256 * 1024, 256, 1024, p.g_pre_mix + l * DM};
    } else if (j == 10) t = TJob{win, INC, 2400, 4096, 1024, (bf16_t*)(wl + OW_G), 4096, 1024, p.g_pre_mix + l * DM};
    else if (j < 15) { const int i = j - 11; t = TJob{p.w_branch + ((size_t)l * 4 + i) * 256 * 1024, 1024, 0, 1024, 256, (bf16_t*)(wl + OW_B) + (size_t)i * 1024 * 256, 1024, 256, nullptr}; }
    else if (j == 15) t = TJob{p.w_out + (size_t)l * DM * DM, 1024, 0, 1024, 1024, (bf16_t*)(wl + OW_OUT), 1024, 1024, nullptr};
    else if (j == 16) t = TJob{p.w_mlp_in + (size_t)l * DM * DFF, DFF, 0, 4096, 1024, (bf16_t*)(wl + OW_1), 4096, 1024, p.g_pre_mlp + l * DM};
    else if (j == 17) t = TJob{p.w_mlp_out + (size_t)l * DFF * DM, 1024, 0, 1024, 4096, (bf16_t*)(wl + OW_2), 1024, 4096, nullptr};
    else if (j < 22) { const int h = j - 18; t = TJob{p.d_w_uq + (size_t)l * 192 * 384, 384, h * 96, 64, 192, (bf16_t*)(wl + OW_UQ) + (size_t)(h * 64) * 256, 64, 256, p.d_q_norm_g + l * 192}; }
    else if (j < 26) { const int h = j - 22; t = TJob{p.d_w_uq + (size_t)l * 192 * 384, 384, h * 96 + 64, 32, 192, (bf16_t*)(wl + OW_UQ) + (size_t)(256 + h * 32) * 256, 32, 256, p.d_q_norm_g + l * 192}; }
    else if (j == 26) t = TJob{p.d_w_uq, 384, 0, 0, 0, (bf16_t*)(wl + OW_UQ) + (size_t)384 * 256, 128, 256, nullptr};
    else if (j < 31) { const int h = j - 27; t = TJob{p.d_w_ukv + (size_t)l * 128 * 512, 512, h * 128, 64, 128, (bf16_t*)(wl + OW_UKV) + (size_t)(h * 64) * 128, 64, 128, p.d_kv_norm_g + l * 128}; }
    else { const int h = j - 31; t = TJob{p.d_w_ukv + (size_t)l * 128 * 512, 512, h * 128 + 64, 64, 128, (bf16_t*)(wl + OW_UKV) + (size_t)(256 + h * 64) * 128, 64, 128, p.d_kv_norm_g + l * 128}; }
    return t;
}
DI void transpose_item(const TJob& t, LAS float* scr, int item, int lane) {
    const int nn = t.ndst / 32, kb = item / nn, nb = item % nn, k0 = 64 * kb, n0 = 32 * nb;
    const bool valid = (k0 < t.ksrc) && (n0 < t.nvalid);
    const int c = lane & 7;
    if (valid) {
        float v[32];
        const float* sp = t.src + (size_t)(k0 + (lane >> 5)) * t.src_ld + t.src_col0 + n0 + (lane & 31);
#pragma unroll
        for (int i = 0; i < 32; ++i) v[i] = sp[(size_t)(2 * i) * t.src_ld];
        f32x4 g0 = (f32x4){1.f, 1.f, 1.f, 1.f}, g1 = g0;
        if (t.g) { g0 = *(const f32x4*)(t.g + k0 + 8 * c); g1 = *(const f32x4*)(t.g + k0 + 8 * c + 4); }
#pragma unroll
        for (int i = 0; i < 32; ++i) scr[(2 * i + (lane >> 5)) * 33 + (lane & 31)] = v[i];
        asm volatile("s_waitcnt lgkmcnt(0)" ::: "memory");
#pragma unroll
        for (int j = 0; j < 4; ++j) { const int n = (lane >> 3) + 8 * j; const LAS float* s = scr + (8 * c) * 33 + n;
            u32x4 o; o.x = cvtpk(s[0 * 33] * g0[0], s[1 * 33] * g0[1]); o.y = cvtpk(s[2 * 33] * g0[2], s[3 * 33] * g0[3]); o.z = cvtpk(s[4 * 33] * g1[0], s[5 * 33] * g1[1]); o.w = cvtpk(s[6 * 33] * g1[2], s[7 * 33] * g1[3]);
            *(u32x4*)(t.dst + (size_t)(n0 + n) * t.kdst + k0 + 8 * c) = o; }
        asm volatile("s_waitcnt lgkmcnt(0)" ::: "memory");
    } else {
#pragma unroll
        for (int j = 0; j < 4; ++j) { const int n = (lane >> 3) + 8 * j; *(u32x4*)(t.dst + (size_t)(n0 + n) * t.kdst + k0 + 8 * c) = (u32x4){0u, 0u, 0u, 0u}; }
    }
}
DI void sincos_d(float af, float& s_out, float& c_out) {
    const double a = (double)af; const double q = rint(a * 0.63661977236758134308);
    double r = fma(-q, 1.57079632679489655800e+00, a); r = fma(-q, 6.12323399573676603587e-17, r);
    const double r2 = r * r;
    double sp = -7.6471637318198164759e-13; sp = fma(sp, r2, 1.6059043836821614599e-10); sp = fma(sp, r2, -2.5052108385441718775e-08); sp = fma(sp, r2, 2.7557319223985890653e-06);
    sp = fma(sp, r2, -1.9841269841269841270e-04); sp = fma(sp, r2, 8.3333333333333333333e-03); sp = fma(sp, r2, -1.6666666666666666667e-01); const double sn = fma(sp * r2, r, r);
    double cp = 4.7794773323873852974e-14; cp = fma(cp, r2, -1.1470745597729724714e-11); cp = fma(cp, r2, 2.0876756987868098979e-09); cp = fma(cp, r2, -2.7557319223985890653e-07);
    cp = fma(cp, r2, 2.4801587301587301587e-05); cp = fma(cp, r2, -1.3888888888888888889e-03); cp = fma(cp, r2, 4.1666666666666666667e-02); cp = fma(cp, r2, -0.5); const double cs = fma(cp, r2, 1.0);
    const int qi = ((int)q) & 3;
    const double s = (qi == 0) ? sn : (qi == 1) ? cs : (qi == 2) ? -sn : -cs;
    const double c = (qi == 0) ? cs : (qi == 1) ? -sn : (qi == 2) ? -cs : sn;
    s_out = (float)s; c_out = (float)c;
}

__global__ void __launch_bounds__(512, 2) hybrid_fwd(Params p) {
    extern __shared__ __attribute__((aligned(16))) unsigned char lds_raw[];
    LAS unsigned char* lds = (LAS unsigned char*)lds_raw;
    cg::grid_group grid = cg::this_grid();
    const int tid = threadIdx.x, lane = tid & 63, wid = __builtin_amdgcn_readfirstlane(tid >> 6);
    const int G = gridDim.x, bx = blockIdx.x;
    unsigned char* ws = p.ws;
    float* cosb = (float*)(ws + WS_TAB + TB_COSB); float* sinb = (float*)(ws + WS_TAB + TB_SINB);
    float* cosd = (float*)(ws + WS_TAB + TB_COSD); float* sind = (float*)(ws + WS_TAB + TB_SIND);
    float* rs0 = (float*)(ws + WS_RS0); float* rs1 = (float*)(ws + WS_RS1); float* rsq = (float*)(ws + WS_RSQ); float* rskv = (float*)(ws + WS_RSKV);
    float* kpart = (float*)(ws + WS_KPART);
    bf16_t* xb = (bf16_t*)(ws + WS_XB);
    unsigned char* Pb = ws + WS_P; unsigned char* Ub = ws + WS_U;

    {
        LAS float* scr = (LAS float*)(lds + wid * 16384);
        const int gw = bx * 8 + wid, NGW = G * 8;
        for (int l = 0; l < NL; ++l)
            for (int j = 0; j < 35; ++j) { const TJob t = get_job(p, l, j); const int nit = (t.kdst / 64) * (t.ndst / 32);
                for (int it = gw; it < nit; it += NGW) transpose_item(t, scr, it, lane); }
        const int gt = bx * 512 + tid, NGT = G * 512;
        for (int idx = gt; idx < NL * 65536; idx += NGT) { const int l = idx >> 16, e = idx & 65535, tt = (e >> 7) & 127, s = e & 127;
            const float v = (s <= tt) ? p.a_w_s[idx] : 0.f; ((bf16_t*)(ws + WS_W + (size_t)l * W_LAYER + OW_S))[e] = (bf16_t)(cvtpk(v, 0.f) & 0xffffu); }
        for (int idx = gt; idx < SEQ * 8; idx += NGT) { const int pos = idx >> 3, i = idx & 7; const float ang = (float)pos * p.invb[i]; float s, c; sincos_d(ang, s, c); cosb[idx] = c; sinb[idx] = s; }
        for (int idx = gt; idx < SEQ * 16; idx += NGT) { const int pos = idx >> 4, i = idx & 15; const float ang = (float)pos * p.invd[i]; float s, c; sincos_d(ang, s, c); cosd[idx] = c; sind[idx] = s; }
        for (int panel = bx; panel < NPANEL; panel += G) prep_panel(p.x + (size_t)panel * 256 * DM, xb + (size_t)panel * 256 * DM, rs0 + panel * 256, wid, lane);
    }
    grid.sync();

    for (int l = 0; l < NL; ++l) {
        unsigned char* wl = ws + WS_W + (size_t)l * W_LAYER;
        for (int panel = bx; panel < NPANEL; panel += G) {
            unsigned char* Pp = Pb + (size_t)panel * PSTRIDE; unsigned char* Up = Ub + (size_t)panel * USTRIDE;
            const int pos0 = (panel & 15) * 256;
            {
                pg8::Gemm g{xb, (const bf16_t*)(wl + OW_IN), 1024, 1024, 1024}; pg8::Seq S{10, panel, 0, 0, 1};
                EpiInProj E{(bf16_t*)Pp, rs0 + panel * 256, cosb, sinb, cosd, sind, kpart + (size_t)panel * 512, pos0};
                pg8::gemm_phase<EpiInProj>(lds, g, S, E);
            }
            {
                const int tq = opaque_tid(); const int row = tq >> 1, hf = tq & 1;
                const bf16_t* cq = (const bf16_t*)(Pp + B_CQ * BUFB) + row * 256 + hf * 96; float s = 0.f;
#pragma unroll
                for (int k = 0; k < 12; ++k) { const bf16x8 v = *(const bf16x8*)(cq + 8 * k);
#pragma unroll
                    for (int e = 0; e < 8; ++e) { const float f = bf2f(v[e]); s += f * f; } }
                s += __shfl_xor(s, 1);
                const bf16_t* ck = (const bf16_t*)(Pp + B_CKV * BUFB) + row * 256 + hf * 64; float s2 = 0.f;
#pragma unroll
                for (int k = 0; k < 8; ++k) { const bf16x8 v = *(const bf16x8*)(ck + 8 * k);
#pragma unroll
                    for (int e = 0; e < 8; ++e) { const float f = bf2f(v[e]); s2 += f * f; } }
                s2 += __shfl_xor(s2, 1);
                if (hf == 0) { rsq[panel * 256 + row] = 1.0f / sqrtf(s * (1.f / 192.f) + EPS); rskv[panel * 256 + row] = 1.0f / sqrtf(s2 * (1.f / 128.f) + EPS); }
                __syncthreads();
            }
            {
                pg8::Gemm g{(const bf16_t*)(Pp + B_CQ * BUFB), (const bf16_t*)(wl + OW_UQ), 256, 256, 256}; pg8::Seq S{2, 0, 0, 0, 1};
                EpiUpQ E{(bf16_t*)(Up + U_QD), rsq + panel * 256, cosd, sind, pos0};
                pg8::gemm_phase<EpiUpQ>(lds, g, S, E);
            }
            {
                pg8::Gemm g{(const bf16_t*)(Pp + B_CKV * BUFB), (const bf16_t*)(wl + OW_UKV), 256, 128, 128}; pg8::Seq S{2, 0, 0, 0, 1};
                EpiUpKV E{(bf16_t*)(Up + U_KD), (bf16_t*)(Up + U_VD), rskv + panel * 256};
                pg8::gemm_phase<EpiUpKV>(lds, g, S, E);
            }
            for (int c = 0; c < 2; ++c) {
                constexpr int VS = 272;
                {
                    const int tq = opaque_tid(); const int t = tq >> 2, part = tq & 3;
                    const bf16_t* vp = (const bf16_t*)(Pp + B_AV * BUFB) + (128 * c + t) * 256 + part * 64;
                    bf16x8 vv[8]; float s = 0.f, s2 = 0.f;
#pragma unroll
                    for (int k = 0; k < 8; ++k) { vv[k] = *(const bf16x8*)(vp + 8 * k);
#pragma unroll
                        for (int e = 0; e < 8; ++e) { const float f = bf2f(vv[k][e]); s += f; s2 += f * f; } }
                    s += __shfl_xor(s, 1); s += __shfl_xor(s, 2); s2 += __shfl_xor(s2, 1); s2 += __shfl_xor(s2, 2);
                    const float mean = s * (1.f / 256.f), var = fmaxf(s2 * (1.f / 256.f) - mean * mean, 0.f), rstd = 1.0f / sqrtf(var + 1e-5f);
                    const float* lg = p.a_ln_g + l * 256 + part * 64; const float* lb = p.a_ln_b + l * 256 + part * 64;
#pragma unroll
                    for (int k = 0; k < 8; ++k)
#pragma unroll
                        for (int e = 0; e < 8; ++e) { const int ch = part * 64 + 8 * k + e; const float f = (bf2f(vv[k][e]) - mean) * rstd * lg[8 * k + e] + lb[8 * k + e];
                            *(LAS unsigned short*)(lds + ch * VS + t * 2) = (unsigned short)(cvtpk(f, 0.f) & 0xffffu); }
                }
                __syncthreads();
                {
                    const int tq = opaque_tid(); const int lq = tq & 63; const int g4 = wid & 3, th = wid >> 2, r = lq & 31, hh = lq >> 5;
                    const bf16_t* Wg = (const bf16_t*)(wl + OW_S) + (size_t)g4 * 128 * 128;
                    const float* bs = p.a_b_s + (l * 4 + g4) * 128;
                    bf16_t* au = (bf16_t*)(Pp + B_AU * BUFB);
#pragma unroll
                    for (int tb = 0; tb < 2; ++tb) {
                        const int t0 = 64 * th + 32 * tb;
                        f32x16 a0, a1;
#pragma unroll
                        for (int i = 0; i < 16; ++i) { a0[i] = 0.f; a1[i] = 0.f; }
                        for (int ks = 0; 16 * ks <= t0 + 31; ++ks) {
                            const bf16x8 wa = *(const bf16x8*)(Wg + (t0 + r) * 128 + 16 * ks + 8 * hh);
                            const bf16x8 b0 = *(const LAS bf16x8*)(lds + (64 * g4 + r) * VS + (16 * ks + 8 * hh) * 2);
                            const bf16x8 b1 = *(const LAS bf16x8*)(lds + (64 * g4 + 32 + r) * VS + (16 * ks + 8 * hh) * 2);
                            a0 = MFMA32(wa, b0, a0); a1 = MFMA32(wa, b1, a1);
                        }
#pragma unroll
                        for (int i = 0; i < 16; ++i) { const int t = t0 + crow(i, hh); const float bb = bs[t]; bf16_t* up = au + (128 * c + t) * 256 + 64 * g4 + r;
                            const float u0 = bf2f((short)up[0]), u1 = bf2f((short)up[32]);
                            up[0] = (bf16_t)(cvtpk(u0 * (a0[i] + bb), 0.f) & 0xffffu); up[32] = (bf16_t)(cvtpk(u1 * (a1[i] + bb), 0.f) & 0xffffu); }
                    }
                }
                __syncthreads();
            }
        }
        grid.sync();
        for (int panel = bx; panel < NPANEL; panel += G) {
            unsigned char* Pp = Pb + (size_t)panel * PSTRIDE; const int pos0 = (panel & 15) * 256;
            const float* wc = p.c_w_conv + l * 3 * 256;
            const int tqc = opaque_tid();
            for (int it = 0; it < 16; ++it) {
                const int item = it * 512 + tqc, row = item >> 5, ch = (item & 31) * 8; const int pos = pos0 + row;
                float z[3][8];
#pragma unroll
                for (int d = 0; d < 3; ++d) {
                    if (pos - d >= 0) { const int rr = row - d; const unsigned char* Pz = rr >= 0 ? Pp : Pp - PSTRIDE; const int ri = rr >= 0 ? rr : rr + 256;
                        const bf16x8 cc = *(const bf16x8*)((const bf16_t*)(Pz + B_CC * BUFB) + ri * 256 + ch), cx = *(const bf16x8*)((const bf16_t*)(Pz + B_CX * BUFB) + ri * 256 + ch);
#pragma unroll
                        for (int e = 0; e < 8; ++e) z[d][e] = bf2f(cc[e]) * bf2f(cx[e]); }
                    else {
#pragma unroll
                        for (int e = 0; e < 8; ++e) z[d][e] = 0.f; }
                }
                bf16_t* cbp = (bf16_t*)(Pp + B_CB * BUFB) + row * 256 + ch; const bf16x8 cb = *(const bf16x8*)cbp; float o[8];
#pragma unroll
                for (int e = 0; e < 8; ++e) o[e] = bf2f(cb[e]) * (wc[ch + e] * z[2][e] + wc[256 + ch + e] * z[1][e] + wc[512 + ch + e] * z[0][e]);
                u32x4 w; w.x = cvtpk(o[0], o[1]); w.y = cvtpk(o[2], o[3]); w.z = cvtpk(o[4], o[5]); w.w = cvtpk(o[6], o[7]);
                *(u32x4*)cbp = w;
            }
        }
        for (int v = bx; v < 256; v += G) {
            const int bh = v >> 2, s = v & 3, b = bh >> 2, h = bh & 3;
            for (int i = 0; i < 4; ++i) { const int qb = (i == 0) ? s : (i == 1) ? 7 - s : (i == 2) ? 8 + s : 15 - s;
                attn_unit<64, true>(b, h, qb, Pb, Ub, kpart, lds, B_BQ);
                attn_unit<96, false>(b, h, qb, Pb, Ub, kpart, lds, B_CQ); }
        }
        grid.sync();
        for (int panel = bx; panel < NPANEL; panel += G) {
            unsigned char* Pp = Pb + (size_t)panel * PSTRIDE; unsigned char* Up = Ub + (size_t)panel * USTRIDE;
            for (int pnn = 0; pnn < 4; ++pnn) {
                {
                    pg8::Gemm g{xb, (const bf16_t*)(wl + OW_G), 1024, 1024, 1024}; pg8::Seq S{4, panel, 0, pnn, 4};
                    EpiG E{Up + U_G, rs0 + panel * 256};
                    pg8::gemm_phase<EpiG>(lds, g, S, E);
                }
                {
                    pg8::Gemm g{(const bf16_t*)Pp, (const bf16_t*)(wl + OW_B), 256, 256, 256}; pg8::Seq S{4, 0, 1, pnn, 4};
                    EpiY E{Up + U_G, Up + U_M, (bf16_t*)(Up + U_MERGED), pnn};
                    pg8::gemm_phase<EpiY>(lds, g, S, E);
                }
            }
            {
                pg8::Gemm g{(const bf16_t*)(Up + U_MERGED), (const bf16_t*)(wl + OW_OUT), 1024, 1024, 1024}; pg8::Seq S{4, 0, 0, 0, 1};
                EpiF32 E{(float*)Pp, 0};
                pg8::gemm_phase<EpiF32>(lds, g, S, E);
            }
            float* xo = p.out + (size_t)panel * 256 * DM;
            norm_step((const float*)Pp, (l == 0) ? p.x + (size_t)panel * 256 * DM : xo, xo, xb + (size_t)panel * 256 * DM, rs1 + panel * 256, p.g_post_mix + l * DM, wid, lane);
            __syncthreads();
            for (int hf = 0; hf < 2; ++hf) {
                {
                    pg8::Gemm g{xb, (const bf16_t*)(wl + OW_1), 1024, 1024, 1024}; pg8::Seq S{8, panel, 0, hf * 8, 1};
                    EpiMlpIn E{(bf16_t*)Up, rs1 + panel * 256, hf * 8};
                    pg8::gemm_phase<EpiMlpIn>(lds, g, S, E);
                }
                {
                    pg8::Gemm g{(const bf16_t*)Up, (const bf16_t*)(wl + OW_2) + hf * 2048, 2048, 4096, 2048}; pg8::Seq S{4, 0, 0, 0, 1};
                    EpiF32 E{(float*)Pp, hf};
                    pg8::gemm_phase<EpiF32>(lds, g, S, E);
                }
            }
            norm_step((const float*)Pp, xo, xo, xb + (size_t)panel * 256 * DM, rs0 + panel * 256, p.g_post_mlp + l * DM, wid, lane);
            __syncthreads();
        }
    }
}

extern "C" void kernel_launch(void* const* d_in, const int* in_sizes, int n_in, void* d_out, int out_size, void* d_ws, size_t ws_size, hipStream_t stream) {
    static int grid = 0;
    if (grid == 0) {
        if (n_in != 19 || out_size != T * DM || ws_size < WS_END) { fprintf(stderr, "kernel_launch: unexpected shapes (n_in %d out %d ws %zu need %zu)\n", n_in, out_size, ws_size, (size_t)WS_END); grid = -1; return; }
        int dev = 0, cus = 0, per_cu = 0;
        hipGetDevice(&dev); hipDeviceGetAttribute(&cus, hipDeviceAttributeMultiprocessorCount, dev);
        hipFuncSetAttribute((const void*)hybrid_fwd, hipFuncAttributeMaxDynamicSharedMemorySize, LDS_BYTES);
        hipOccupancyMaxActiveBlocksPerMultiprocessor(&per_cu, (const void*)hybrid_fwd, 512, LDS_BYTES);
        if (per_cu < 1) per_cu = 1;
        (void)hipGetLastError();
        grid = cus * per_cu; if (grid > 256) grid = 256;
    }
    if (grid < 0) return;
    Params p{};
    const float** pp = (const float**)&p;
    for (int i = 0; i < 19; ++i) pp[i] = (const float*)d_in[i];
    p.out = (float*)d_out; p.ws = (unsigned char*)d_ws;
    for (int i = 0; i < 8; ++i) p.invb[i] = 1.0f / powf(500000.0f, (float)(2 * i) / 16.0f);
    for (int i = 0; i < 16; ++i) p.invd[i] = 1.0f / powf(500000.0f, (float)(2 * i) / 32.0f);
    void* args[] = {&p};
    hipError_t e = hipLaunchCooperativeKernel((const void*)hybrid_fwd, dim3(grid), dim3(512), args, LDS_BYTES, stream);
    if (e != hipSuccess) fprintf(stderr, "cooperative launch failed: %s (grid %d)\n", hipGetErrorString(e), grid);
}
```

```cpp
#include <hip/hip_runtime.h>
#include <hip/hip_cooperative_groups.h>
#include <cstdio>
#include <cstdint>
#include <cmath>
namespace cg = cooperative_groups;

#define LAS __attribute__((address_space(3)))
typedef unsigned short bf16_t;
typedef short bf16x8 __attribute__((ext_vector_type(8)));
typedef short s16x4 __attribute__((ext_vector_type(4)));
typedef float f32x4 __attribute__((ext_vector_type(4)));
typedef float f32x2 __attribute__((ext_vector_type(2)));
typedef float f32x16 __attribute__((ext_vector_type(16)));
typedef unsigned u32x4 __attribute__((ext_vector_type(4)));
typedef unsigned u32x2 __attribute__((ext_vector_type(2)));
typedef __bf16 bf16x2_t __attribute__((ext_vector_type(2)));
#define DI __device__ __forceinline__

constexpr int T = 65536, DM = 1024, SEQ = 4096, NPANEL = 256, NL = 4, INC = 6496, DFF = 4096;
constexpr float EPS = 1e-6f;
constexpr float LOG2E = 1.4426950408889634f;
constexpr float C2M = 0.125f * LOG2E;
constexpr float C2D = 0.10206207261596575f * LOG2E;

constexpr size_t SZ_WIN = 2560ull * 1024 * 2, SZ_WG = 4096ull * 1024 * 2, SZ_WB = 4096ull * 256 * 2, SZ_WOUT = 1024ull * 1024 * 2,
                 SZ_W1 = 4096ull * 1024 * 2, SZ_W2 = 1024ull * 4096 * 2, SZ_WUQ = 512ull * 256 * 2, SZ_WUKV = 512ull * 128 * 2, SZ_WS = 4ull * 128 * 128 * 2;
constexpr size_t OW_IN = 0, OW_G = OW_IN + SZ_WIN, OW_B = OW_G + SZ_WG, OW_OUT = OW_B + SZ_WB, OW_1 = OW_OUT + SZ_WOUT, OW_2 = OW_1 + SZ_W1,
                 OW_UQ = OW_2 + SZ_W2, OW_UKV = OW_UQ + SZ_WUQ, OW_S = OW_UKV + SZ_WUKV, W_LAYER = OW_S + SZ_WS;
constexpr size_t WS_W = 0;
constexpr size_t WS_TAB = WS_W + NL * W_LAYER;
constexpr size_t TB_COSB = 0, TB_SINB = 131072, TB_COSD = 262144, TB_SIND = 524288, SZ_TAB = 786432;
constexpr size_t WS_RS0 = WS_TAB + SZ_TAB, WS_RS1 = WS_RS0 + 262144, WS_RSQ = WS_RS1 + 262144, WS_RSKV = WS_RSQ + 262144;
constexpr size_t WS_KPART = WS_RSKV + 262144;
constexpr size_t WS_XB = WS_KPART + 524288;
constexpr size_t WS_P = WS_XB + (size_t)T * DM * 2;
constexpr size_t BUFB = 256ull * 256 * 2, PSTRIDE = 10 * BUFB;
constexpr size_t WS_U = WS_P + NPANEL * PSTRIDE;
constexpr size_t USTRIDE = PSTRIDE;
constexpr size_t WS_END = WS_U + NPANEL * USTRIDE;
constexpr size_t U_QD = 0, U_KD = 196608, U_VD = 327680;
constexpr size_t U_G = 0, U_M = 524288, U_MERGED = 786432;
enum { B_AU = 0, B_BQ = 1, B_CB = 2, B_CQ = 3, B_AV = 4, B_BK = 5, B_BV = 6, B_CC = 7, B_CX = 8, B_CKV = 9 };

constexpr int RING_BYTES = 131072, LDS_BYTES = 147456;

DI int opaque_tid() { int t = threadIdx.x; asm volatile("" : "+v"(t)); return t; }
DI unsigned cvtpk(float lo, float hi) { f32x2 v = {lo, hi}; bf16x2_t b = __builtin_convertvector(v, bf16x2_t); return __builtin_bit_cast(unsigned, b); }
DI float bf2f(short s) { return __uint_as_float(((unsigned)(unsigned short)s) << 16); }
DI float wave_sum(float v) {
#pragma unroll
    for (int o = 1; o < 64; o <<= 1) v += __shfl_xor(v, o);
    return v;
}
DI float gelu_tanh(float v) {
    const float z = 0.7978845608028654f * (v + 0.044715f * v * v * v);
    return v * __builtin_amdgcn_rcpf(1.f + __builtin_amdgcn_exp2f(-2.f * LOG2E * z));
}
DI float sigmoidf_(float v) { return __builtin_amdgcn_rcpf(1.f + __builtin_amdgcn_exp2f(-LOG2E * v)); }

namespace pg8 {
constexpr int BM = 256, BK = 64, HALF = 128, HTB = HALF * BK * 2;
DI int lds_byte(int r, int c) { const int st = (r >> 4) * 2 + (c >> 5), rr = r & 15, cc = c & 31, ob = rr * 64 + cc * 2; return st * 1024 + (ob ^ (((ob >> 9) & 1) << 5)); }
DI void stage_rc(int b, int& R, int& C) { const int st = b / 1024, sb = b % 1024, swz = sb ^ (((sb >> 9) & 1) << 5); R = (st >> 1) * 16 + swz / 64; C = (st & 1) * 32 + (swz % 64) / 2; }
DI int perm32(int rho) { const int n = rho >> 4, i = rho & 15; return 8 * (i >> 2) + 4 * n + (i & 3); }
struct Unit { int pm, pn; };
struct Gemm { const bf16_t* A; const bf16_t* Bt; int lda, ldb, K; size_t astride; };
struct Seq { int n, q0, qs, nper, pm0, pmpl, pmr, pn0, pnpl, pnr;
    DI bool next(int i, Unit& u) const { if (i >= n) return false; const int q = q0 + i * qs, pl = q / nper, r = q - pl * nper;
        u.pm = pm0 + pl * pmpl + r * pmr; u.pn = pn0 + pl * pnpl + r * pnr; return true; } };

template <class Epi>
DI void gemm_phase(LAS unsigned char* lds, const Gemm g, const Seq& S_in, const Epi& E) {
    Seq S = S_in; asm volatile("" : "+s"(S.n));
    const int tid = opaque_tid(), wid = __builtin_amdgcn_readfirstlane(tid >> 6), lane = tid & 63, wr = wid >> 2, wc = wid & 3, fr = lane & 15, fq = lane >> 4;
    int K = g.K; asm volatile("" : "+s"(K)); const int nt = K / BK;
    unsigned voffA[2], voffB[2];
#pragma unroll
    for (int i = 0; i < 2; ++i) { int R, C; stage_rc(tid * 16 + i * 8192, R, C); const int Rb = Epi::PERM ? ((R & ~31) + perm32(R & 31)) : R;
        voffA[i] = (unsigned)(R * g.lda + C) * 2u; voffB[i] = (unsigned)(Rb * g.ldb + C) * 2u; }
    const size_t kstep = (size_t)(BK * 2);
    const size_t hstepA = (size_t)HALF * g.lda * 2, hstepB = (size_t)HALF * g.ldb * 2;
    const size_t tstepA = g.astride, tstepB = 2 * hstepB;
    const unsigned ldsw = (unsigned)wid * 1024u;
    const int aoff = lds_byte(wr * 64 + fr, fq * 8), boff = lds_byte(wc * 32 + fr, fq * 8);
#define PG8_SA(b, h) (((b) * 2 + (h)) * HTB)
#define PG8_SB(b, h) ((4 + (b) * 2 + (h)) * HTB)
#define PG8_STAGE(bufoff, gbase, voff) do { _Pragma("unroll") for (int _i = 0; _i < 2; ++_i) \
        __builtin_amdgcn_global_load_lds((const unsigned*)((const char*)(gbase) + (voff)[_i]), (LAS unsigned*)(lds + (bufoff) + ldsw + _i * 8192), 16, 0, 0); } while (0)
#define PG8_LDA(dst, b, h) do { _Pragma("unroll") for (int m = 0; m < 4; ++m) _Pragma("unroll") for (int k = 0; k < 2; ++k) dst[m][k] = *(const LAS bf16x8*)(lds + PG8_SA(b, h) + aoff + m * 2048 + k * 1024); } while (0)
#define PG8_LDB(dst, b, h) do { _Pragma("unroll") for (int n = 0; n < 2; ++n) _Pragma("unroll") for (int k = 0; k < 2; ++k) dst[n][k] = *(const LAS bf16x8*)(lds + PG8_SB(b, h) + boff + n * 2048 + k * 1024); } while (0)
#define PG8_MMA(ai, bj, At, Bt) do { __builtin_amdgcn_s_setprio(1); _Pragma("unroll") for (int m = 0; m < 4; ++m) _Pragma("unroll") for (int n = 0; n < 2; ++n) _Pragma("unroll") for (int k = 0; k < 2; ++k) \
        acc[ai][bj][m][n] = __builtin_amdgcn_mfma_f32_16x16x32_bf16(Bt[n][k], At[m][k], acc[ai][bj][m][n], 0, 0, 0); __builtin_amdgcn_s_setprio(0); } while (0)
#define PG8_WAIT_V(n) asm volatile("s_waitcnt vmcnt(" #n ")" ::: "memory")
#define PG8_WAIT_L(n) asm volatile("s_waitcnt lgkmcnt(" #n ")" ::: "memory")
#define PG8_BAR __builtin_amdgcn_s_barrier()
#define PG8_SCHED __builtin_amdgcn_sched_barrier(0)
    Unit cur, nxt; int ui = 0;
    if (!S.next(0, cur)) return;
    f32x4 acc[2][2][4][2];
#pragma unroll
    for (int a = 0; a < 2; ++a)
#pragma unroll
        for (int b = 0; b < 2; ++b)
#pragma unroll
            for (int m = 0; m < 4; ++m)
#pragma unroll
                for (int n = 0; n < 2; ++n) acc[a][b][m][n] = (f32x4){0.f, 0.f, 0.f, 0.f};
    bf16x8 At[4][2], B0[2][2], B1[2][2];
    const char* cA = (const char*)g.A + (size_t)cur.pm * tstepA; const char* cB = (const char*)g.Bt + (size_t)cur.pn * tstepB;
    PG8_STAGE(PG8_SB(0, 0), cB, voffB); PG8_STAGE(PG8_SB(0, 1), cB + hstepB, voffB); PG8_STAGE(PG8_SA(0, 0), cA, voffA); PG8_STAGE(PG8_SA(0, 1), cA + hstepA, voffA);
    if (wr == 1) PG8_BAR;
    PG8_WAIT_V(2); PG8_BAR;
    PG8_STAGE(PG8_SB(1, 0), cB + kstep, voffB); PG8_STAGE(PG8_SA(1, 0), cA + kstep, voffA); PG8_STAGE(PG8_SB(1, 1), cB + hstepB + kstep, voffB);
    PG8_WAIT_V(6); PG8_BAR;
    for (;;) {
        const bool has_next = S.next(ui + 1, nxt);
        const char* nA = has_next ? (const char*)g.A + (size_t)nxt.pm * tstepA : cA; const char* nB = has_next ? (const char*)g.Bt + (size_t)nxt.pn * tstepB : cB;
#pragma nounroll
        for (int t = 0; t < nt; t += 2) {
            const bool last = (t == nt - 2);
            const char* a1 = cA + (size_t)(t + 1) * kstep;
            const char* a2 = last ? nA : cA + (size_t)(t + 2) * kstep; const char* b2 = last ? nB : cB + (size_t)(t + 2) * kstep;
            const char* a3 = a2 + kstep; const char* b3 = b2 + kstep;
            PG8_LDB(B0, 0, 0); PG8_LDB(B1, 0, 1); PG8_SCHED; PG8_LDA(At, 0, 0); PG8_STAGE(PG8_SA(1, 1), a1 + hstepA, voffA);
            PG8_WAIT_V(8); PG8_WAIT_L(0); PG8_BAR; PG8_MMA(0, 0, At, B0); PG8_MMA(0, 1, At, B1); PG8_BAR; PG8_SCHED;
            PG8_LDA(At, 0, 1); PG8_STAGE(PG8_SB(0, 0), b2, voffB); PG8_STAGE(PG8_SB(0, 1), b2 + hstepB, voffB); PG8_STAGE(PG8_SA(0, 0), a2, voffA);
            PG8_WAIT_V(8); PG8_WAIT_L(0); PG8_BAR; PG8_MMA(1, 0, At, B0); PG8_MMA(1, 1, At, B1); PG8_BAR; PG8_SCHED;
            PG8_LDB(B0, 1, 0); PG8_LDB(B1, 1, 1); PG8_SCHED; PG8_LDA(At, 1, 0); PG8_STAGE(PG8_SA(0, 1), a2 + hstepA, voffA);
            PG8_WAIT_V(8); PG8_WAIT_L(0); PG8_BAR; PG8_MMA(0, 0, At, B0); PG8_MMA(0, 1, At, B1); PG8_BAR; PG8_SCHED;
            PG8_LDA(At, 1, 1); PG8_STAGE(PG8_SB(1, 0), b3, voffB); PG8_STAGE(PG8_SB(1, 1), b3 + hstepB, voffB); PG8_STAGE(PG8_SA(1, 0), a3, voffA);
            PG8_WAIT_V(8); PG8_WAIT_L(0); PG8_BAR; PG8_MMA(1, 0, At, B0); PG8_MMA(1, 1, At, B1); PG8_BAR; PG8_SCHED;
        }
        if (wr == 0) PG8_BAR;
        E(acc, cur, wr, wc, fr, fq);
        if (!has_next) break;
#pragma unroll
        for (int a = 0; a < 2; ++a)
#pragma unroll
            for (int b = 0; b < 2; ++b)
#pragma unroll
                for (int m = 0; m < 4; ++m)
#pragma unroll
                    for (int n = 0; n < 2; ++n) acc[a][b][m][n] = (f32x4){0.f, 0.f, 0.f, 0.f};
        cur = nxt; cA = nA; cB = nB; ++ui;
        if (wr == 1) PG8_BAR;
    }
    PG8_WAIT_V(0);
    PG8_BAR;
#undef PG8_SA
#undef PG8_SB
#undef PG8_STAGE
#undef PG8_LDA
#undef PG8_LDB
#undef PG8_MMA
#undef PG8_WAIT_V
#undef PG8_WAIT_L
#undef PG8_BAR
#undef PG8_SCHED
}
}
using pg8::Unit;
typedef f32x4 Acc[2][2][4][2];

struct EpiInProj {
    static constexpr bool PERM = true;
    unsigned char* Pb_; const float* rs0_; const float* cosb; const float* sinb; const float* cosd; const float* sind; float* kpart_;
    DI void operator()(const Acc& acc, const Unit& u, int wr, int wc, int fr, int fq) const {
        asm volatile("" : "+v"(fr), "+v"(fq));
        const int panel = u.pm; bf16_t* Pp = (bf16_t*)(Pb_ + (size_t)panel * PSTRIDE); const float* rs = rs0_ + panel * 256; float* kpart = kpart_ + (size_t)panel * 512; const int pos0 = (panel & 15) * 256;
        const int tile = u.pn; bf16_t* dst = Pp + (size_t)tile * 65536;
        const bool act = (tile == B_AU) || (tile == B_AV);
        const bool rope16 = ((tile == B_BQ) || (tile == B_BK)) && ((wc & 1) == 0);
        const float qs = (tile == B_BQ) ? C2M : 1.f;
        float csum[2][8];
#pragma unroll
        for (int bj = 0; bj < 2; ++bj)
#pragma unroll
            for (int e = 0; e < 8; ++e) csum[bj][e] = 0.f;
#pragma unroll
        for (int ai = 0; ai < 2; ++ai)
#pragma unroll
            for (int m = 0; m < 4; ++m) {
                const int row = ai * 128 + wr * 64 + m * 16 + fr; const float r = rs[row] * qs; const int pos = pos0 + row;
#pragma unroll
                for (int bj = 0; bj < 2; ++bj) {
                    const int c0 = bj * 128 + wc * 32 + fq * 8;
                    float v[8];
#pragma unroll
                    for (int e = 0; e < 8; ++e) v[e] = acc[ai][bj][m][e >> 2][e & 3] * r;
                    if (act) {
#pragma unroll
                        for (int e = 0; e < 8; ++e) v[e] = gelu_tanh(v[e]);
                    }
                    if (rope16) {
                        const f32x4 ca = *(const f32x4*)(cosb + pos * 8), cb2 = *(const f32x4*)(cosb + pos * 8 + 4);
                        const f32x4 sa = *(const f32x4*)(sinb + pos * 8), sb2 = *(const f32x4*)(sinb + pos * 8 + 4);
#pragma unroll
                        for (int e = 0; e < 8; ++e) { const float o = __shfl_xor(v[e], 16); const float c = e < 4 ? ca[e & 3] : cb2[e & 3], s = e < 4 ? sa[e & 3] : sb2[e & 3];
                            const float rot = (fq == 0) ? (v[e] * c - o * s) : (v[e] * c + o * s); if (fq < 2) v[e] = rot; }
                    }
                    if (tile == B_CKV && bj == 1 && wc == 0) {
                        const int ib = 8 * (fq & 1);
                        const f32x4 ca = *(const f32x4*)(cosd + pos * 16 + ib), cb2 = *(const f32x4*)(cosd + pos * 16 + ib + 4);
                        const f32x4 sa = *(const f32x4*)(sind + pos * 16 + ib), sb2 = *(const f32x4*)(sind + pos * 16 + ib + 4);
#pragma unroll
                        for (int e = 0; e < 8; ++e) { const float o = __shfl_xor(v[e], 32); const float c = e < 4 ? ca[e & 3] : cb2[e & 3], s = e < 4 ? sa[e & 3] : sb2[e & 3];
                            v[e] = (fq < 2) ? (v[e] * c - o * s) : (v[e] * c + o * s); }
                    }
                    if (tile == B_BK) {
#pragma unroll
                        for (int e = 0; e < 8; ++e) csum[bj][e] += v[e];
                    }
                    u32x4 w; w.x = cvtpk(v[0], v[1]); w.y = cvtpk(v[2], v[3]); w.z = cvtpk(v[4], v[5]); w.w = cvtpk(v[6], v[7]);
                    *(u32x4*)(dst + row * 256 + c0) = w;
                }
                asm volatile("" ::: "memory");
            }
        if (tile == B_BK) {
#pragma unroll
            for (int bj = 0; bj < 2; ++bj)
#pragma unroll
                for (int e = 0; e < 8; ++e) { float s = csum[bj][e]; s += __shfl_xor(s, 1); s += __shfl_xor(s, 2); s += __shfl_xor(s, 4); s += __shfl_xor(s, 8);
                    if (fr == 0) kpart[wr * 256 + bj * 128 + wc * 32 + fq * 8 + e] = s; }
        }
    }
};
struct EpiUpQ {
    static constexpr bool PERM = true;
    bf16_t* Qp; const float* rsq; const float* cosd; const float* sind; int pos0;
    DI void operator()(const Acc& acc, const Unit& u, int wr, int wc, int fr, int fq) const {
        asm volatile("" : "+v"(fr), "+v"(fq));
        const int tile = u.pn;
#pragma unroll
        for (int ai = 0; ai < 2; ++ai)
#pragma unroll
            for (int m = 0; m < 4; ++m) {
                const int row = ai * 128 + wr * 64 + m * 16 + fr; const float r = rsq[row] * C2D; const int pos = pos0 + row;
#pragma unroll
                for (int bj = 0; bj < 2; ++bj) {
                    float v[8];
#pragma unroll
                    for (int e = 0; e < 8; ++e) v[e] = acc[ai][bj][m][e >> 2][e & 3] * r;
                    if (tile == 0) {
                        const int c0 = bj * 128 + wc * 32 + fq * 8, head = c0 >> 6, e0 = c0 & 63;
                        u32x4 w; w.x = cvtpk(v[0], v[1]); w.y = cvtpk(v[2], v[3]); w.z = cvtpk(v[4], v[5]); w.w = cvtpk(v[6], v[7]);
                        *(u32x4*)(Qp + row * 384 + head * 96 + e0) = w;
                    } else if (bj == 0) {
                        const int ib = 8 * (fq & 1);
                        const f32x4 ca = *(const f32x4*)(cosd + pos * 16 + ib), cb2 = *(const f32x4*)(cosd + pos * 16 + ib + 4);
                        const f32x4 sa = *(const f32x4*)(sind + pos * 16 + ib), sb2 = *(const f32x4*)(sind + pos * 16 + ib + 4);
#pragma unroll
                        for (int e = 0; e < 8; ++e) { const float o = __shfl_xor(v[e], 32); const float c = e < 4 ? ca[e & 3] : cb2[e & 3], s = e < 4 ? sa[e & 3] : sb2[e & 3];
                            v[e] = (fq < 2) ? (v[e] * c - o * s) : (v[e] * c + o * s); }
                        u32x4 w; w.x = cvtpk(v[0], v[1]); w.y = cvtpk(v[2], v[3]); w.z = cvtpk(v[4], v[5]); w.w = cvtpk(v[6], v[7]);
                        *(u32x4*)(Qp + row * 384 + wc * 96 + 64 + fq * 8) = w;
                    }
                }
                asm volatile("" ::: "memory");
            }
    }
};
struct EpiUpKV {
    static constexpr bool PERM = true;
    bf16_t* Kp; bf16_t* Vp; const float* rskv;
    DI void operator()(const Acc& acc, const Unit& u, int wr, int wc, int fr, int fq) const {
        asm volatile("" : "+v"(fr), "+v"(fq));
        bf16_t* dst = u.pn == 0 ? Kp : Vp;
#pragma unroll
        for (int ai = 0; ai < 2; ++ai)
#pragma unroll
            for (int m = 0; m < 4; ++m) {
                const int row = ai * 128 + wr * 64 + m * 16 + fr; const float r = rskv[row];
#pragma unroll
                for (int bj = 0; bj < 2; ++bj) {
                    const int c0 = bj * 128 + wc * 32 + fq * 8; float v[8];
#pragma unroll
                    for (int e = 0; e < 8; ++e) v[e] = acc[ai][bj][m][e >> 2][e & 3] * r;
                    u32x4 w; w.x = cvtpk(v[0], v[1]); w.y = cvtpk(v[2], v[3]); w.z = cvtpk(v[4], v[5]); w.w = cvtpk(v[6], v[7]);
                    *(u32x4*)(dst + row * 256 + c0) = w;
                }
                asm volatile("" ::: "memory");
            }
    }
};
struct EpiG {
    static constexpr bool PERM = true;
    unsigned char* Gs; const float* rs;
    DI void operator()(const Acc& acc, const Unit& u, int wr, int wc, int fr, int fq) const {
        asm volatile("" : "+v"(fr), "+v"(fq));
        const int br = u.pn >> 2; u32x4* g = (u32x4*)(Gs + (size_t)br * 131072) + opaque_tid();
#pragma unroll
        for (int ai = 0; ai < 2; ++ai)
#pragma unroll
            for (int m = 0; m < 4; ++m) {
                const int row = ai * 128 + wr * 64 + m * 16 + fr; const float r = rs[row];
#pragma unroll
                for (int bj = 0; bj < 2; ++bj) {
                    float v[8];
#pragma unroll
                    for (int e = 0; e < 8; ++e) v[e] = sigmoidf_(acc[ai][bj][m][e >> 2][e & 3] * r);
                    u32x4 w; w.x = cvtpk(v[0], v[1]); w.y = cvtpk(v[2], v[3]); w.z = cvtpk(v[4], v[5]); w.w = cvtpk(v[6], v[7]);
                    g[((ai * 2 + bj) * 4 + m) * 512] = w;
                }
                asm volatile("" ::: "memory");
            }
    }
};
struct EpiY {
    static constexpr bool PERM = true;
    unsigned char* Gs; unsigned char* Ms; bf16_t* merged; int pnn; int brbase;
    DI void operator()(const Acc& acc, const Unit& u, int wr, int wc, int fr, int fq) const {
        asm volatile("" : "+v"(fr), "+v"(fq));
        const int br = u.pm - brbase; const int tq = opaque_tid(); const u32x4* g = (const u32x4*)(Gs + (size_t)br * 131072) + tq; f32x4* ms = (f32x4*)Ms + tq;
#pragma unroll
        for (int ai = 0; ai < 2; ++ai)
#pragma unroll
            for (int m = 0; m < 4; ++m) {
                const int row = ai * 128 + wr * 64 + m * 16 + fr;
#pragma unroll
                for (int bj = 0; bj < 2; ++bj) {
                    const int k = (ai * 2 + bj) * 4 + m; const u32x4 gw = g[k * 512];
                    float gt[8]; gt[0] = __uint_as_float(gw.x << 16); gt[1] = __uint_as_float(gw.x & 0xffff0000u); gt[2] = __uint_as_float(gw.y << 16); gt[3] = __uint_as_float(gw.y & 0xffff0000u);
                    gt[4] = __uint_as_float(gw.z << 16); gt[5] = __uint_as_float(gw.z & 0xffff0000u); gt[6] = __uint_as_float(gw.w << 16); gt[7] = __uint_as_float(gw.w & 0xffff0000u);
                    f32x4 v0, v1;
#pragma unroll
                    for (int e = 0; e < 4; ++e) { v0[e] = acc[ai][bj][m][0][e] * gt[e]; v1[e] = acc[ai][bj][m][1][e] * gt[4 + e]; }
                    if (br > 0) { v0 += ms[(2 * k) * 512]; v1 += ms[(2 * k + 1) * 512]; }
                    if (br < 3) { ms[(2 * k) * 512] = v0; ms[(2 * k + 1) * 512] = v1; }
                    else { const int c0 = pnn * 256 + bj * 128 + wc * 32 + fq * 8;
                        u32x4 w; w.x = cvtpk(v0[0], v0[1]); w.y = cvtpk(v0[2], v0[3]); w.z = cvtpk(v1[0], v1[1]); w.w = cvtpk(v1[2], v1[3]);
                        *(u32x4*)(merged + row * 1024 + c0) = w; }
                }
                asm volatile("" ::: "memory");
            }
    }
};
struct EpiF32 {
    static constexpr bool PERM = false;
    float* Yb; int accum;
    DI void operator()(const Acc& acc, const Unit& u, int wr, int wc, int fr, int fq) const {
        asm volatile("" : "+v"(fr), "+v"(fq));
        float* Y = Yb + (size_t)u.pm * (PSTRIDE / 4);
#pragma unroll
        for (int ai = 0; ai < 2; ++ai)
#pragma unroll
            for (int m = 0; m < 4; ++m) {
                const int row = ai * 128 + wr * 64 + m * 16 + fr;
#pragma unroll
                for (int bj = 0; bj < 2; ++bj)
#pragma unroll
                    for (int n = 0; n < 2; ++n) { f32x4* p = (f32x4*)(Y + row * 1024 + u.pn * 256 + bj * 128 + wc * 32 + n * 16 + fq * 4);
                        f32x4 v = acc[ai][bj][m][n]; if (accum) v += *p; *p = v; }
                asm volatile("" ::: "memory");
            }
    }
};
struct EpiMlpIn {
    static constexpr bool PERM = true;
    unsigned char* Ub_; const float* rs1_; int pn_base;
    DI void operator()(const Acc& acc, const Unit& u, int wr, int wc, int fr, int fq) const {
        asm volatile("" : "+v"(fr), "+v"(fq));
        bf16_t* Uo = (bf16_t*)(Ub_ + (size_t)u.pm * USTRIDE); const float* rs = rs1_ + u.pm * 256;
        const int ct = (u.pn - pn_base) * 256;
#pragma unroll
        for (int ai = 0; ai < 2; ++ai)
#pragma unroll
            for (int m = 0; m < 4; ++m) {
                const int row = ai * 128 + wr * 64 + m * 16 + fr; const float r = rs[row];
#pragma unroll
                for (int bj = 0; bj < 2; ++bj) {
                    const int c0 = ct + bj * 128 + wc * 32 + fq * 8; float v[8];
#pragma unroll
                    for (int e = 0; e < 8; ++e) { const float t = fmaxf(acc[ai][bj][m][e >> 2][e & 3] * r, 0.f); v[e] = t * t; }
                    u32x4 w; w.x = cvtpk(v[0], v[1]); w.y = cvtpk(v[2], v[3]); w.z = cvtpk(v[4], v[5]); w.w = cvtpk(v[6], v[7]);
                    *(u32x4*)(Uo + row * 2048 + c0) = w;
                }
                asm volatile("" ::: "memory");
            }
    }
};

DI int crow(int r, int hi) { return (r & 3) + 8 * (r >> 2) + 4 * hi; }
#define MFMA32(a, b, c) __builtin_amdgcn_mfma_f32_32x32x16_bf16((a), (b), (c), 0, 0, 0)
template <int DQK, bool MOBA>
DI void attn_unit(int b, int h, int qb, unsigned char* P, unsigned char* U, const float* kpart, LAS unsigned char* lds, int obuf) {
    constexpr int ND0 = DQK / 16, KSTR = DQK * 2 + 16, VSTR = 144;
    constexpr int L_K = 0, L_V = 13312, L_KM = 22528;
    constexpr float NEG = -1e30f;
    const int tid = opaque_tid(), lane = tid & 63, wid = __builtin_amdgcn_readfirstlane(tid >> 6), r = lane & 31, hh = lane >> 5;
    const int panel_q = b * 16 + qb;
    unsigned char* Pq = P + (size_t)panel_q * PSTRIDE; unsigned char* Uq = U + (size_t)panel_q * USTRIDE;
    const bf16_t* qrow = MOBA ? (const bf16_t*)(Pq + B_BQ * BUFB) + (32 * wid + r) * 256 + h * 64 : (const bf16_t*)(Uq + U_QD) + (32 * wid + r) * 384 + h * 96;
    bf16x8 qf[ND0];
#pragma unroll
    for (int d0 = 0; d0 < ND0; ++d0) qf[d0] = *(const bf16x8*)(qrow + 16 * d0 + 8 * hh);
    unsigned mask = 0xffffffffu;
    if (MOBA) {
        LAS float* km = (LAS float*)(lds + L_KM);
        __syncthreads();
        for (int idx = tid; idx < qb * 64; idx += 512) { const int n = idx >> 6, d = idx & 63; const float* kp = kpart + (size_t)(b * 16 + n) * 512 + h * 64 + d; km[idx] = (kp[0] + kp[256]) * (1.f / 256.f); }
        __syncthreads();
        if (qb <= 3) mask = (1u << qb) - 1u;
        else {
            float qv[ND0 * 8];
#pragma unroll
            for (int d0 = 0; d0 < ND0; ++d0)
#pragma unroll
                for (int j = 0; j < 8; ++j) qv[d0 * 8 + j] = bf2f(qf[d0][j]);
            float v1 = -INFINITY, v2 = -INFINITY, v3 = -INFINITY; int i1 = -1, i2 = -1, i3 = -1;
            for (int n = 0; n < qb; ++n) {
                float g = 0.f;
#pragma unroll
                for (int d0 = 0; d0 < ND0; ++d0)
#pragma unroll
                    for (int j = 0; j < 8; ++j) g += qv[d0 * 8 + j] * km[n * 64 + 16 * d0 + 8 * hh + j];
                g += __shfl_xor(g, 32);
                if (g > v1) { v3 = v2; i3 = i2; v2 = v1; i2 = i1; v1 = g; i1 = n; }
                else if (g > v2) { v3 = v2; i3 = i2; v2 = g; i2 = n; }
                else if (g > v3) { v3 = g; i3 = n; }
            }
            mask = (1u << i1) | (1u << i2) | (1u << i3);
        }
    }
    const int NT = 4 * (qb + 1);
    const int lkey = tid >> 3, lch = tid & 7;
    u32x4 kreg, vreg, kreg2 = (u32x4){0u, 0u, 0u, 0u};
#define ATT_LOAD(kt) do { const int kp_ = b * 16 + ((kt) >> 2), r0_ = 64 * ((kt) & 3); \
        const unsigned char* Pk_ = P + (size_t)kp_ * PSTRIDE; const unsigned char* Uk_ = U + (size_t)kp_ * USTRIDE; \
        const bf16_t* ks_ = MOBA ? (const bf16_t*)(Pk_ + B_BK * BUFB) : (const bf16_t*)(Uk_ + U_KD); \
        const bf16_t* vs_ = MOBA ? (const bf16_t*)(Pk_ + B_BV * BUFB) : (const bf16_t*)(Uk_ + U_VD); \
        kreg = *(const u32x4*)(ks_ + (r0_ + lkey) * 256 + h * 64 + 8 * lch); \
        vreg = *(const u32x4*)(vs_ + (r0_ + lkey) * 256 + h * 64 + 8 * lch); \
        if (!MOBA && tid < 256) kreg2 = *(const u32x4*)((const bf16_t*)(Pk_ + B_CKV * BUFB) + (r0_ + (tid >> 2)) * 256 + 128 + 8 * (tid & 3)); } while (0)
    float mrun = NEG, lrun = 0.f;
    f32x16 o0, o1;
#pragma unroll
    for (int i = 0; i < 16; ++i) { o0[i] = 0.f; o1[i] = 0.f; }
    ATT_LOAD(0);
    for (int kt = 0; kt < NT; ++kt) {
        __syncthreads();
        *(LAS u32x4*)(lds + L_K + lkey * KSTR + lch * 16) = kreg;
        if (!MOBA && tid < 256) *(LAS u32x4*)(lds + L_K + (tid >> 2) * KSTR + 128 + (tid & 3) * 16) = kreg2;
        {
            LAS unsigned short* vt = (LAS unsigned short*)(lds + L_V + (8 * lch) * VSTR + lkey * 2);
            vt[0 * (VSTR / 2)] = (unsigned short)(vreg.x & 0xffffu); vt[1 * (VSTR / 2)] = (unsigned short)(vreg.x >> 16);
            vt[2 * (VSTR / 2)] = (unsigned short)(vreg.y & 0xffffu); vt[3 * (VSTR / 2)] = (unsigned short)(vreg.y >> 16);
            vt[4 * (VSTR / 2)] = (unsigned short)(vreg.z & 0xffffu); vt[5 * (VSTR / 2)] = (unsigned short)(vreg.z >> 16);
            vt[6 * (VSTR / 2)] = (unsigned short)(vreg.w & 0xffffu); vt[7 * (VSTR / 2)] = (unsigned short)(vreg.w >> 16);
        }
        __syncthreads();
        if (kt + 1 < NT) ATT_LOAD(kt + 1);
        const int nblk = kt >> 2; const bool diag = (nblk == qb); const int kr0 = 64 * (kt & 3);
        if (diag && kr0 > 32 * wid + 31) continue;
        bool lane_sel = true;
        if (MOBA && !diag) { lane_sel = ((mask >> nblk) & 1u) != 0u; if (!__any(lane_sel)) continue; }
        f32x16 p0, p1;
#pragma unroll
        for (int i = 0; i < 16; ++i) { p0[i] = 0.f; p1[i] = 0.f; }
#pragma unroll
        for (int d0 = 0; d0 < ND0; ++d0) {
            const bf16x8 a0 = *(const LAS bf16x8*)(lds + L_K + r * KSTR + (16 * d0 + 8 * hh) * 2);
            const bf16x8 a1 = *(const LAS bf16x8*)(lds + L_K + (32 + r) * KSTR + (16 * d0 + 8 * hh) * 2);
            p0 = MFMA32(a0, qf[d0], p0); p1 = MFMA32(a1, qf[d0], p1);
        }
        if (diag) { const int qr = 32 * wid + r;
#pragma unroll
            for (int i = 0; i < 16; ++i) { const int kk = kr0 + crow(i, hh); if (kk > qr) p0[i] = NEG; if (kk + 32 > qr) p1[i] = NEG; } }
        if (MOBA && !diag && !lane_sel) {
#pragma unroll
            for (int i = 0; i < 16; ++i) { p0[i] = NEG; p1[i] = NEG; } }
        float mx = fmaxf(p0[0], p1[0]);
#pragma unroll
        for (int i = 1; i < 16; ++i) mx = fmaxf(mx, fmaxf(p0[i], p1[i]));
        mx = fmaxf(mx, __shfl_xor(mx, 32));
        const float mnew = fmaxf(mrun, mx), alpha = __builtin_amdgcn_exp2f(mrun - mnew); mrun = mnew;
        float ps = 0.f;
#pragma unroll
        for (int i = 0; i < 16; ++i) { p0[i] = __builtin_amdgcn_exp2f(p0[i] - mnew); p1[i] = __builtin_amdgcn_exp2f(p1[i] - mnew); ps += p0[i] + p1[i]; }
        lrun = lrun * alpha + ps;
#pragma unroll
        for (int i = 0; i < 16; ++i) { o0[i] *= alpha; o1[i] *= alpha; }
#pragma unroll
        for (int kh = 0; kh < 2; ++kh)
#pragma unroll
            for (int s = 0; s < 2; ++s) {
                u32x4 pw;
                if (kh == 0) { pw.x = cvtpk(p0[8 * s], p0[8 * s + 1]); pw.y = cvtpk(p0[8 * s + 2], p0[8 * s + 3]); pw.z = cvtpk(p0[8 * s + 4], p0[8 * s + 5]); pw.w = cvtpk(p0[8 * s + 6], p0[8 * s + 7]); }
                else { pw.x = cvtpk(p1[8 * s], p1[8 * s + 1]); pw.y = cvtpk(p1[8 * s + 2], p1[8 * s + 3]); pw.z = cvtpk(p1[8 * s + 4], p1[8 * s + 5]); pw.w = cvtpk(p1[8 * s + 6], p1[8 * s + 7]); }
                const bf16x8 pf = __builtin_bit_cast(bf16x8, pw);
                const int kb = (32 * kh + 16 * s + 4 * hh) * 2;
                {   const u32x2 lo = *(const LAS u32x2*)(lds + L_V + r * VSTR + kb), hi = *(const LAS u32x2*)(lds + L_V + r * VSTR + kb + 16);
                    const u32x4 vv = (u32x4){lo.x, lo.y, hi.x, hi.y}; o0 = MFMA32(__builtin_bit_cast(bf16x8, vv), pf, o0); }
                {   const u32x2 lo = *(const LAS u32x2*)(lds + L_V + (32 + r) * VSTR + kb), hi = *(const LAS u32x2*)(lds + L_V + (32 + r) * VSTR + kb + 16);
                    const u32x4 vv = (u32x4){lo.x, lo.y, hi.x, hi.y}; o1 = MFMA32(__builtin_bit_cast(bf16x8, vv), pf, o1); }
            }
    }
#undef ATT_LOAD
    lrun += __shfl_xor(lrun, 32);
    const float rl = 1.f / lrun;
    bf16_t* orow = (bf16_t*)(Pq + (size_t)obuf * BUFB) + (32 * wid + r) * 256 + h * 64;
#pragma unroll
    for (int g4 = 0; g4 < 4; ++g4) {
        u32x2 w0, w1;
        w0.x = cvtpk(o0[4 * g4] * rl, o0[4 * g4 + 1] * rl); w0.y = cvtpk(o0[4 * g4 + 2] * rl, o0[4 * g4 + 3] * rl);
        w1.x = cvtpk(o1[4 * g4] * rl, o1[4 * g4 + 1] * rl); w1.y = cvtpk(o1[4 * g4 + 2] * rl, o1[4 * g4 + 3] * rl);
        *(u32x2*)(orow + 8 * g4 + 4 * hh) = w0; *(u32x2*)(orow + 32 + 8 * g4 + 4 * hh) = w1;
    }
}

struct Params {
    const float* x; const float* g_pre_mix; const float* w_in; const float* a_ln_g; const float* a_ln_b; const float* a_w_s; const float* a_b_s; const float* c_w_conv;
    const float* d_q_norm_g; const float* d_w_uq; const float* d_kv_norm_g; const float* d_w_ukv; const float* w_branch; const float* w_out; const float* g_post_mix;
    const float* g_pre_mlp; const float* w_mlp_in; const float* w_mlp_out; const float* g_post_mlp;
    float* out; unsigned char* ws;
    float invb[8]; float invd[16];
};

DI void norm_step(const float* y, const float* xsrc, float* xdst, bf16_t* xb, float* rs_out, const float* gain, int wid, int lane_) {
    int lane = lane_; asm volatile("" : "+v"(lane));
    f32x4 gv[4];
#pragma unroll
    for (int j = 0; j < 4; ++j) gv[j] = *(const f32x4*)(gain + 4 * lane + 256 * j);
    for (int rr = 0; rr < 32; rr += 4) {
        f32x4 yv[4][4], xv[4][4];
#pragma unroll
        for (int q = 0; q < 4; ++q)
#pragma unroll
            for (int j = 0; j < 4; ++j) { const int row = wid * 32 + rr + q; yv[q][j] = *(const f32x4*)(y + row * 1024 + 4 * lane + 256 * j); xv[q][j] = *(const f32x4*)(xsrc + (size_t)row * 1024 + 4 * lane + 256 * j); }
#pragma unroll
        for (int q = 0; q < 4; ++q) {
            const int row = wid * 32 + rr + q; float ss = 0.f;
#pragma unroll
            for (int j = 0; j < 4; ++j) ss += yv[q][j].x * yv[q][j].x + yv[q][j].y * yv[q][j].y + yv[q][j].z * yv[q][j].z + yv[q][j].w * yv[q][j].w;
            const float ry = 1.0f / sqrtf(wave_sum(ss) * (1.f / 1024.f) + EPS); float s2 = 0.f;
#pragma unroll
            for (int j = 0; j < 4; ++j) { const f32x4 xn = xv[q][j] + yv[q][j] * ry * gv[j];
                *(f32x4*)(xdst + (size_t)row * 1024 + 4 * lane + 256 * j) = xn; s2 += xn.x * xn.x + xn.y * xn.y + xn.z * xn.z + xn.w * xn.w;
                u32x2 w; w.x = cvtpk(xn.x, xn.y); w.y = cvtpk(xn.z, xn.w); *(u32x2*)(xb + (size_t)row * 1024 + 4 * lane + 256 * j) = w; }
            s2 = wave_sum(s2);
            if (lane == 0) rs_out[row] = 1.0f / sqrtf(s2 * (1.f / 1024.f) + EPS);
        }
    }
}
DI void prep_panel(const float* xsrc, bf16_t* xb, float* rs_out, int wid, int lane_) {
    int lane = lane_; asm volatile("" : "+v"(lane));
    for (int rr = 0; rr < 32; rr += 4) {
        f32x4 xv[4][4];
#pragma unroll
        for (int q = 0; q < 4; ++q)
#pragma unroll
            for (int j = 0; j < 4; ++j) xv[q][j] = *(const f32x4*)(xsrc + (size_t)(wid * 32 + rr + q) * 1024 + 4 * lane + 256 * j);
#pragma unroll
        for (int q = 0; q < 4; ++q) {
            const int row = wid * 32 + rr + q; float s2 = 0.f;
#pragma unroll
            for (int j = 0; j < 4; ++j) { const f32x4 xn = xv[q][j]; s2 += xn.x * xn.x + xn.y * xn.y + xn.z * xn.z + xn.w * xn.w;
                u32x2 w; w.x = cvtpk(xn.x, xn.y); w.y = cvtpk(xn.z, xn.w); *(u32x2*)(xb + (size_t)row * 1024 + 4 * lane + 256 * j) = w; }
            s2 = wave_sum(s2);
            if (lane == 0) rs_out[row] = 1.0f / sqrtf(s2 * (1.f / 1024.f) + EPS);
        }
    }
}
struct TJob { const float* src; int src_ld, src_col0, nvalid, ksrc; bf16_t* dst; int ndst, kdst; const float* g; };
DI TJob get_job(const Params& p, int l, int j) {
    unsigned char* wl = p.ws + WS_W + (size_t)l * W_LAYER; TJob t;
    const float* win = p.w_in + (size_t)l * DM * INC;
    if (j < 10) {
        const int st[10] = {0, 512, 1280, 2048, 256, 768, 1024, 1536, 1792, 2240}; const int nv[10] = {256, 256, 256, 192, 256, 256, 256, 256, 256, 160};
        int s0 = 0, n0 = 0;
#pragma unroll
        for (int q = 0; q < 10; ++q) if (q == j) { s0 = st[q]; n0 = nv[q]; }
        t = TJob{win, INC, s0, n0, 1024, (bf16_t*)(wl + OW_IN) + (size_t)j * 256 * 1024, 256, 1024, p.g_pre_mix + l * DM};
    } else if (j == 10) t = TJob{win, INC, 2400, 4096, 1024, (bf16_t*)(wl + OW_G), 4096, 1024, p.g_pre_mix + l * DM};
    else if (j < 15) { const int i = j - 11; t = TJob{p.w_branch + ((size_t)l * 4 + i) * 256 * 1024, 1024, 0, 1024, 256, (bf16_t*)(wl + OW_B) + (size_t)i * 1024 * 256, 1024, 256, nullptr}; }
    else if (j == 15) t = TJob{p.w_out + (size_t)l * DM * DM, 1024, 0, 1024, 1024, (bf16_t*)(wl + OW_OUT), 1024, 1024, nullptr};
    else if (j == 16) t = TJob{p.w_mlp_in + (size_t)l * DM * DFF, DFF, 0, 4096, 1024, (bf16_t*)(wl + OW_1), 4096, 1024, p.g_pre_mlp + l * DM};
    else if (j == 17) t = TJob{p.w_mlp_out + (size_t)l * DFF * DM, 1024, 0, 1024, 4096, (bf16_t*)(wl + OW_2), 1024, 4096, nullptr};
    else if (j < 22) { const int h = j - 18; t = TJob{p.d_w_uq + (size_t)l * 192 * 384, 384, h * 96, 64, 192, (bf16_t*)(wl + OW_UQ) + (size_t)(h * 64) * 256, 64, 256, p.d_q_norm_g + l * 192}; }
    else if (j < 26) { const int h = j - 22; t = TJob{p.d_w_uq + (size_t)l * 192 * 384, 384, h * 96 + 64, 32, 192, (bf16_t*)(wl + OW_UQ) + (size_t)(256 + h * 32) * 256, 32, 256, p.d_q_norm_g + l * 192}; }
    else if (j == 26) t = TJob{p.d_w_uq, 384, 0, 0, 0, (bf16_t*)(wl + OW_UQ) + (size_t)384 * 256, 128, 256, nullptr};
    else if (j < 31) { const int h = j - 27; t = TJob{p.d_w_ukv + (size_t)l * 128 * 512, 512, h * 128, 64, 128, (bf16_t*)(wl + OW_UKV) + (size_t)(h * 64) * 128, 64, 128, p.d_kv_norm_g + l * 128}; }
    else { const int h = j - 31; t = TJob{p.d_w_ukv + (size_t)l * 128 * 512, 512, h * 128 + 64, 64, 128, (bf16_t*)(wl + OW_UKV) + (size_t)(256 + h * 64) * 128, 64, 128, p.d_kv_norm_g + l * 128}; }
    return t;
}
DI void transpose_item(const TJob& t, LAS float* scr, int item, int lane) {
    const int nn = t.ndst / 32, kb = item / nn, nb = item % nn, k0 = 64 * kb, n0 = 32 * nb;
    const bool valid = (k0 < t.ksrc) && (n0 < t.nvalid);
    const int c = lane & 7;
    if (valid) {
        float v[32];
        const float* sp = t.src + (size_t)(k0 + (lane >> 5)) * t.src_ld + t.src_col0 + n0 + (lane & 31);
#pragma unroll
        for (int i = 0; i < 32; ++i) v[i] = sp[(size_t)(2 * i) * t.src_ld];
        f32x4 g0 = (f32x4){1.f, 1.f, 1.f, 1.f}, g1 = g0;
        if (t.g) { g0 = *(const f32x4*)(t.g + k0 + 8 * c); g1 = *(const f32x4*)(t.g + k0 + 8 * c + 4); }
#pragma unroll
        for (int i = 0; i < 32; ++i) scr[(2 * i + (lane >> 5)) * 33 + (lane & 31)] = v[i];
        asm volatile("s_waitcnt lgkmcnt(0)" ::: "memory");
#pragma unroll
        for (int j = 0; j < 4; ++j) { const int n = (lane >> 3) + 8 * j; const LAS float* s = scr + (8 * c) * 33 + n;
            u32x4 o; o.x = cvtpk(s[0 * 33] * g0[0], s[1 * 33] * g0[1]); o.y = cvtpk(s[2 * 33] * g0[2], s[3 * 33] * g0[3]); o.z = cvtpk(s[4 * 33] * g1[0], s[5 * 33] * g1[1]); o.w = cvtpk(s[6 * 33] * g1[2], s[7 * 33] * g1[3]);
            *(u32x4*)(t.dst + (size_t)(n0 + n) * t.kdst + k0 + 8 * c) = o; }
        asm volatile("s_waitcnt lgkmcnt(0)" ::: "memory");
    } else {
#pragma unroll
        for (int j = 0; j < 4; ++j) { const int n = (lane >> 3) + 8 * j; *(u32x4*)(t.dst + (size_t)(n0 + n) * t.kdst + k0 + 8 * c) = (u32x4){0u, 0u, 0u, 0u}; }
    }
}
DI void sincos_d(float af, float& s_out, float& c_out) {
    const double a = (double)af; const double q = rint(a * 0.63661977236758134308);
    double r = fma(-q, 1.57079632679489655800e+00, a); r = fma(-q, 6.12323399573676603587e-17, r);
    const double r2 = r * r;
    double sp = -7.6471637318198164759e-13; sp = fma(sp, r2, 1.6059043836821614599e-10); sp = fma(sp, r2, -2.5052108385441718775e-08); sp = fma(sp, r2, 2.7557319223985890653e-06);
    sp = fma(sp, r2, -1.9841269841269841270e-04); sp = fma(sp, r2, 8.3333333333333333333e-03); sp = fma(sp, r2, -1.6666666666666666667e-01); const double sn = fma(sp * r2, r, r);
    double cp = 4.7794773323873852974e-14; cp = fma(cp, r2, -1.1470745597729724714e-11); cp = fma(cp, r2, 2.0876756987868098979e-09); cp = fma(cp, r2, -2.7557319223985890653e-07);
    cp = fma(cp, r2, 2.4801587301587301587e-05); cp = fma(cp, r2, -1.3888888888888888889e-03); cp = fma(cp, r2, 4.1666666666666666667e-02); cp = fma(cp, r2, -0.5); const double cs = fma(cp, r2, 1.0);
    const int qi = ((int)q) & 3;
    const double s = (qi == 0) ? sn : (qi == 1) ? cs : (qi == 2) ? -sn : -cs;
    const double c = (qi == 0) ? cs : (qi == 1) ? -sn : (qi == 2) ? -cs : sn;
    s_out = (float)s; c_out = (float)c;
}

__global__ void __launch_bounds__(512, 2) hybrid_fwd(Params p) {
    extern __shared__ __attribute__((aligned(16))) unsigned char lds_raw[];
    LAS unsigned char* lds = (LAS unsigned char*)lds_raw;
    cg::grid_group grid = cg::this_grid();
    const int tid = threadIdx.x, lane = tid & 63, wid = __builtin_amdgcn_readfirstlane(tid >> 6);
    const int G = gridDim.x, bx = blockIdx.x;
    unsigned char* ws = p.ws;
    float* cosb = (float*)(ws + WS_TAB + TB_COSB); float* sinb = (float*)(ws + WS_TAB + TB_SINB);
    float* cosd = (float*)(ws + WS_TAB + TB_COSD); float* sind = (float*)(ws + WS_TAB + TB_SIND);
    float* rs0 = (float*)(ws + WS_RS0); float* rs1 = (float*)(ws + WS_RS1); float* rsq = (float*)(ws + WS_RSQ); float* rskv = (float*)(ws + WS_RSKV);
    float* kpart = (float*)(ws + WS_KPART);
    bf16_t* xb = (bf16_t*)(ws + WS_XB);
    unsigned char* Pb = ws + WS_P; unsigned char* Ub = ws + WS_U;

    {
        LAS float* scr = (LAS float*)(lds + wid * 16384);
        const int gw = bx * 8 + wid, NGW = G * 8;
        for (int l = 0; l < NL; ++l)
            for (int j = 0; j < 35; ++j) { const TJob t = get_job(p, l, j); const int nit = (t.kdst / 64) * (t.ndst / 32);
                for (int it = gw; it < nit; it += NGW) transpose_item(t, scr, it, lane); }
        const int gt = bx * 512 + tid, NGT = G * 512;
        for (int idx = gt; idx < NL * 65536; idx += NGT) { const int l = idx >> 16, e = idx & 65535, tt = (e >> 7) & 127, s = e & 127;
            const float v = (s <= tt) ? p.a_w_s[idx] : 0.f; ((bf16_t*)(ws + WS_W + (size_t)l * W_LAYER + OW_S))[e] = (bf16_t)(cvtpk(v, 0.f) & 0xffffu); }
        for (int idx = gt; idx < SEQ * 8; idx += NGT) { const int pos = idx >> 3, i = idx & 7; const float ang = (float)pos * p.invb[i]; float s, c; sincos_d(ang, s, c); cosb[idx] = c; sinb[idx] = s; }
        for (int idx = gt; idx < SEQ * 16; idx += NGT) { const int pos = idx >> 4, i = idx & 15; const float ang = (float)pos * p.invd[i]; float s, c; sincos_d(ang, s, c); cosd[idx] = c; sind[idx] = s; }
        for (int panel = bx; panel < NPANEL; panel += G) prep_panel(p.x + (size_t)panel * 256 * DM, xb + (size_t)panel * 256 * DM, rs0 + panel * 256, wid, lane);
    }
    grid.sync();

    const int NG = G >> 3, gid0 = (G == 256) ? ((bx & 7) * 4 + (bx >> 6)) : (bx >> 3), mem = (G == 256) ? ((bx >> 3) & 7) : (bx & 7);
    const bool ingrp = (bx < NG * 8);
    unsigned char* Uw = Ub + (size_t)bx * USTRIDE;
    for (int l = 0; l < NL; ++l) {
        unsigned char* wl = ws + WS_W + (size_t)l * W_LAYER;
        if (ingrp) for (int gq = gid0; gq < 32; gq += NG) {
            pg8::Gemm g{xb, (const bf16_t*)(wl + OW_IN), 1024, 1024, 1024, (size_t)256 * 1024 * 2}; pg8::Seq S{10, mem, 8, 10, gq * 8, 1, 0, 0, 0, 1};
            EpiInProj E{Pb, rs0, cosb, sinb, cosd, sind, kpart};
            pg8::gemm_phase<EpiInProj>(lds, g, S, E);
        }
        grid.sync();
        if (ingrp) for (int gq = gid0; gq < 32; gq += NG) {
            const int panel = gq * 8 + mem;
            unsigned char* Pp = Pb + (size_t)panel * PSTRIDE; unsigned char* Up = Ub + (size_t)panel * USTRIDE;
            const int pos0 = (panel & 15) * 256;
            {
                const int tq = opaque_tid(); const int row = tq >> 1, hf = tq & 1;
                const bf16_t* cq = (const bf16_t*)(Pp + B_CQ * BUFB) + row * 256 + hf * 96; float s = 0.f;
#pragma unroll
                for (int k = 0; k < 12; ++k) { const bf16x8 v = *(const bf16x8*)(cq + 8 * k);
#pragma unroll
                    for (int e = 0; e < 8; ++e) { const float f = bf2f(v[e]); s += f * f; } }
                s += __shfl_xor(s, 1);
                const bf16_t* ck = (const bf16_t*)(Pp + B_CKV * BUFB) + row * 256 + hf * 64; float s2 = 0.f;
#pragma unroll
                for (int k = 0; k < 8; ++k) { const bf16x8 v = *(const bf16x8*)(ck + 8 * k);
#pragma unroll
                    for (int e = 0; e < 8; ++e) { const float f = bf2f(v[e]); s2 += f * f; } }
                s2 += __shfl_xor(s2, 1);
                if (hf == 0) { rsq[panel * 256 + row] = 1.0f / sqrtf(s * (1.f / 192.f) + EPS); rskv[panel * 256 + row] = 1.0f / sqrtf(s2 * (1.f / 128.f) + EPS); }
                __syncthreads();
            }
            {
                pg8::Gemm g{(const bf16_t*)(Pp + B_CQ * BUFB), (const bf16_t*)(wl + OW_UQ), 256, 256, 256, 0}; pg8::Seq S{2, 0, 1, 2, 0, 0, 0, 0, 0, 1};
                EpiUpQ E{(bf16_t*)(Up + U_QD), rsq + panel * 256, cosd, sind, pos0};
                pg8::gemm_phase<EpiUpQ>(lds, g, S, E);
            }
            {
                pg8::Gemm g{(const bf16_t*)(Pp + B_CKV * BUFB), (const bf16_t*)(wl + OW_UKV), 256, 128, 128, 0}; pg8::Seq S{2, 0, 1, 2, 0, 0, 0, 0, 0, 1};
                EpiUpKV E{(bf16_t*)(Up + U_KD), (bf16_t*)(Up + U_VD), rskv + panel * 256};
                pg8::gemm_phase<EpiUpKV>(lds, g, S, E);
            }
            for (int c = 0; c < 2; ++c) {
                constexpr int VS = 272;
                {
                    const int tq = opaque_tid(); const int t = tq >> 2, part = tq & 3;
                    const bf16_t* vp = (const bf16_t*)(Pp + B_AV * BUFB) + (128 * c + t) * 256 + part * 64;
                    bf16x8 vv[8]; float s = 0.f, s2 = 0.f;
#pragma unroll
                    for (int k = 0; k < 8; ++k) { vv[k] = *(const bf16x8*)(vp + 8 * k);
#pragma unroll
                        for (int e = 0; e < 8; ++e) { const float f = bf2f(vv[k][e]); s += f; s2 += f * f; } }
                    s += __shfl_xor(s, 1); s += __shfl_xor(s, 2); s2 += __shfl_xor(s2, 1); s2 += __shfl_xor(s2, 2);
                    const float mean = s * (1.f / 256.f), var = fmaxf(s2 * (1.f / 256.f) - mean * mean, 0.f), rstd = 1.0f / sqrtf(var + 1e-5f);
                    const float* lg = p.a_ln_g + l * 256 + part * 64; const float* lb = p.a_ln_b + l * 256 + part * 64;
#pragma unroll
                    for (int k = 0; k < 8; ++k)
#pragma unroll
                        for (int e = 0; e < 8; ++e) { const int ch = part * 64 + 8 * k + e; const float f = (bf2f(vv[k][e]) - mean) * rstd * lg[8 * k + e] + lb[8 * k + e];
                            *(LAS unsigned short*)(lds + ch * VS + t * 2) = (unsigned short)(cvtpk(f, 0.f) & 0xffffu); }
                }
                __syncthreads();
                {
                    const int tq = opaque_tid(); const int lq = tq & 63; const int g4 = wid & 3, th = wid >> 2, r = lq & 31, hh = lq >> 5;
                    const bf16_t* Wg = (const bf16_t*)(wl + OW_S) + (size_t)g4 * 128 * 128;
                    const float* bs = p.a_b_s + (l * 4 + g4) * 128;
                    bf16_t* au = (bf16_t*)(Pp + B_AU * BUFB);
#pragma unroll
                    for (int tb = 0; tb < 2; ++tb) {
                        const int t0 = 64 * th + 32 * tb;
                        f32x16 a0, a1;
#pragma unroll
                        for (int i = 0; i < 16; ++i) { a0[i] = 0.f; a1[i] = 0.f; }
                        for (int ks = 0; 16 * ks <= t0 + 31; ++ks) {
                            const bf16x8 wa = *(const bf16x8*)(Wg + (t0 + r) * 128 + 16 * ks + 8 * hh);
                            const bf16x8 b0 = *(const LAS bf16x8*)(lds + (64 * g4 + r) * VS + (16 * ks + 8 * hh) * 2);
                            const bf16x8 b1 = *(const LAS bf16x8*)(lds + (64 * g4 + 32 + r) * VS + (16 * ks + 8 * hh) * 2);
                            a0 = MFMA32(wa, b0, a0); a1 = MFMA32(wa, b1, a1);
                        }
#pragma unroll
                        for (int i = 0; i < 16; ++i) { const int t = t0 + crow(i, hh); const float bb = bs[t]; bf16_t* up = au + (128 * c + t) * 256 + 64 * g4 + r;
                            const float u0 = bf2f((short)up[0]), u1 = bf2f((short)up[32]);
                            up[0] = (bf16_t)(cvtpk(u0 * (a0[i] + bb), 0.f) & 0xffffu); up[32] = (bf16_t)(cvtpk(u1 * (a1[i] + bb), 0.f) & 0xffffu); }
                    }
                }
                __syncthreads();
            }
        }
        grid.sync();
        for (int panel = bx; panel < NPANEL; panel += G) {
            unsigned char* Pp = Pb + (size_t)panel * PSTRIDE; const int pos0 = (panel & 15) * 256;
            const float* wc = p.c_w_conv + l * 3 * 256;
            const int tqc = opaque_tid();
            for (int it = 0; it < 16; ++it) {
                const int item = it * 512 + tqc, row = item >> 5, ch = (item & 31) * 8; const int pos = pos0 + row;
                float z[3][8];
#pragma unroll
                for (int d = 0; d < 3; ++d) {
                    if (pos - d >= 0) { const int rr = row - d; const unsigned char* Pz = rr >= 0 ? Pp : Pp - PSTRIDE; const int ri = rr >= 0 ? rr : rr + 256;
                        const bf16x8 cc = *(const bf16x8*)((const bf16_t*)(Pz + B_CC * BUFB) + ri * 256 + ch), cx = *(const bf16x8*)((const bf16_t*)(Pz + B_CX * BUFB) + ri * 256 + ch);
#pragma unroll
                        for (int e = 0; e < 8; ++e) z[d][e] = bf2f(cc[e]) * bf2f(cx[e]); }
                    else {
#pragma unroll
                        for (int e = 0; e < 8; ++e) z[d][e] = 0.f; }
                }
                bf16_t* cbp = (bf16_t*)(Pp + B_CB * BUFB) + row * 256 + ch; const bf16x8 cb = *(const bf16x8*)cbp; float o[8];
#pragma unroll
                for (int e = 0; e < 8; ++e) o[e] = bf2f(cb[e]) * (wc[ch + e] * z[2][e] + wc[256 + ch + e] * z[1][e] + wc[512 + ch + e] * z[0][e]);
                u32x4 w; w.x = cvtpk(o[0], o[1]); w.y = cvtpk(o[2], o[3]); w.z = cvtpk(o[4], o[5]); w.w = cvtpk(o[6], o[7]);
                *(u32x4*)cbp = w;
            }
        }
        for (int v = bx; v < 256; v += G) {
            const int bh = v >> 2, s = v & 3, b = bh >> 2, h = bh & 3;
            for (int i = 0; i < 4; ++i) { const int qb = (i == 0) ? s : (i == 1) ? 7 - s : (i == 2) ? 8 + s : 15 - s;
                attn_unit<64, true>(b, h, qb, Pb, Ub, kpart, lds, B_BQ);
                attn_unit<96, false>(b, h, qb, Pb, Ub, kpart, lds, B_CQ); }
        }
        grid.sync();
        if (ingrp) for (int gq = gid0; gq < 32; gq += NG)
            for (int q = mem; q < 32; q += 8) {
                const int panel = gq * 8 + (q >> 2), pnn = q & 3;
                {
                    pg8::Gemm g{xb, (const bf16_t*)(wl + OW_G), 1024, 1024, 1024, (size_t)256 * 1024 * 2}; pg8::Seq S{4, 0, 1, 4, panel, 0, 0, pnn, 0, 4};
                    EpiG E{Uw + U_G, rs0 + panel * 256};
                    pg8::gemm_phase<EpiG>(lds, g, S, E);
                }
                {
                    pg8::Gemm g{(const bf16_t*)Pb, (const bf16_t*)(wl + OW_B), 256, 256, 256, BUFB}; pg8::Seq S{4, 0, 1, 4, panel * 10, 0, 1, pnn, 0, 4};
                    EpiY E{Uw + U_G, Uw + U_M, (bf16_t*)(Ub + (size_t)panel * USTRIDE + U_MERGED), pnn, panel * 10};
                    pg8::gemm_phase<EpiY>(lds, g, S, E);
                }
            }
        grid.sync();
        if (ingrp) for (int gq = gid0; gq < 32; gq += NG) {
            pg8::Gemm g{(const bf16_t*)(Ub + U_MERGED), (const bf16_t*)(wl + OW_OUT), 1024, 1024, 1024, USTRIDE}; pg8::Seq S{4, mem, 8, 4, gq * 8, 1, 0, 0, 0, 1};
            EpiF32 E{(float*)Pb, 0};
            pg8::gemm_phase<EpiF32>(lds, g, S, E);
        }
        grid.sync();
        for (int panel = bx; panel < NPANEL; panel += G) {
            float* xo = p.out + (size_t)panel * 256 * DM;
            norm_step((const float*)(Pb + (size_t)panel * PSTRIDE), (l == 0) ? p.x + (size_t)panel * 256 * DM : xo, xo, xb + (size_t)panel * 256 * DM, rs1 + panel * 256, p.g_post_mix + l * DM, wid, lane);
        }
        grid.sync();
        for (int hf = 0; hf < 2; ++hf) {
            if (ingrp) for (int gq = gid0; gq < 32; gq += NG) {
                pg8::Gemm g{xb, (const bf16_t*)(wl + OW_1), 1024, 1024, 1024, (size_t)256 * 1024 * 2}; pg8::Seq S{8, mem, 8, 8, gq * 8, 1, 0, hf * 8, 0, 1};
                EpiMlpIn E{Ub, rs1, hf * 8};
                pg8::gemm_phase<EpiMlpIn>(lds, g, S, E);
            }
            grid.sync();
            if (ingrp) for (int gq = gid0; gq < 32; gq += NG) {
                pg8::Gemm g{(const bf16_t*)Ub, (const bf16_t*)(wl + OW_2) + hf * 2048, 2048, 4096, 2048, USTRIDE}; pg8::Seq S{4, mem, 8, 4, gq * 8, 1, 0, 0, 0, 1};
                EpiF32 E{(float*)Pb, hf};
                pg8::gemm_phase<EpiF32>(lds, g, S, E);
            }
            grid.sync();
        }
        for (int panel = bx; panel < NPANEL; panel += G) {
            float* xo = p.out + (size_t)panel * 256 * DM;
            norm_step((const float*)(Pb + (size_t)panel * PSTRIDE), xo, xo, xb + (size_t)panel * 256 * DM, rs0 + panel * 256, p.g_post_mlp + l * DM, wid, lane);
        }
        grid.sync();
    }
}

extern "C" void kernel_launch(void* const* d_in, const int* in_sizes, int n_in, void* d_out, int out_size, void* d_ws, size_t ws_size, hipStream_t stream) {
    static int grid = 0;
    if (grid == 0) {
        if (n_in != 19 || out_size != T * DM || ws_size < WS_END) { fprintf(stderr, "kernel_launch: unexpected shapes (n_in %d out %d ws %zu need %zu)\n", n_in, out_size, ws_size, (size_t)WS_END); grid = -1; return; }
        int dev = 0, cus = 0, per_cu = 0;
        hipGetDevice(&dev); hipDeviceGetAttribute(&cus, hipDeviceAttributeMultiprocessorCount, dev);
        hipFuncSetAttribute((const void*)hybrid_fwd, hipFuncAttributeMaxDynamicSharedMemorySize, LDS_BYTES);
        hipOccupancyMaxActiveBlocksPerMultiprocessor(&per_cu, (const void*)hybrid_fwd, 512, LDS_BYTES);
        if (per_cu < 1) per_cu = 1;
        (void)hipGetLastError();
        grid = cus * per_cu; if (grid > 256) grid = 256;
    }
    if (grid < 0) return;
    Params p{};
    const float** pp = (const float**)&p;
    for (int i = 0; i < 19; ++i) pp[i] = (const float*)d_in[i];
    p.out = (float*)d_out; p.ws = (unsigned char*)d_ws;
    for (int i = 0; i < 8; ++i) p.invb[i] = 1.0f / powf(500000.0f, (float)(2 * i) / 16.0f);
    for (int i = 0; i < 16; ++i) p.invd[i] = 1.0f / powf(500000.0f, (float)(2 * i) / 32.0f);
    void* args[] = {&p};
    hipError_t e = hipLaunchCooperativeKernel((const void*)hybrid_fwd, dim3(grid), dim3(512), args, LDS_BYTES, stream);
    if (e != hipSuccess) fprintf(stderr, "cooperative launch failed: %s (grid %d)\n", hipGetErrorString(e), grid);
}
```

```cpp
#include <hip/hip_runtime.h>
#include <hip/hip_cooperative_groups.h>
#include <cstdio>
#include <cstdint>
#include <cmath>
namespace cg = cooperative_groups;

#define LAS __attribute__((address_space(3)))
typedef unsigned short bf16_t;
typedef short bf16x8 __attribute__((ext_vector_type(8)));
typedef short s16x4 __attribute__((ext_vector_type(4)));
typedef float f32x4 __attribute__((ext_vector_type(4)));
typedef float f32x2 __attribute__((ext_vector_type(2)));
typedef float f32x16 __attribute__((ext_vector_type(16)));
typedef unsigned u32x4 __attribute__((ext_vector_type(4)));
typedef unsigned u32x2 __attribute__((ext_vector_type(2)));
typedef __bf16 bf16x2_t __attribute__((ext_vector_type(2)));
#define DI __device__ __forceinline__

constexpr int T = 65536, DM = 1024, SEQ = 4096, NPANEL = 256, NL = 4, INC = 6496, DFF = 4096;
constexpr float EPS = 1e-6f;
constexpr float LOG2E = 1.4426950408889634f;
constexpr float C2M = 0.125f * LOG2E;
constexpr float C2D = 0.10206207261596575f * LOG2E;

constexpr size_t SZ_WIN = 2560ull * 1024 * 2, SZ_WG = 4096ull * 1024 * 2, SZ_WB = 4096ull * 256 * 2, SZ_WOUT = 1024ull * 1024 * 2,
                 SZ_W1 = 4096ull * 1024 * 2, SZ_W2 = 1024ull * 4096 * 2, SZ_WUQ = 512ull * 256 * 2, SZ_WUKV = 512ull * 128 * 2, SZ_WS = 4ull * 128 * 128 * 2;
constexpr size_t OW_IN = 0, OW_G = OW_IN + SZ_WIN, OW_B = OW_G + SZ_WG, OW_OUT = OW_B + SZ_WB, OW_1 = OW_OUT + SZ_WOUT, OW_2 = OW_1 + SZ_W1,
                 OW_UQ = OW_2 + SZ_W2, OW_UKV = OW_UQ + SZ_WUQ, OW_S = OW_UKV + SZ_WUKV, W_LAYER = OW_S + SZ_WS;
constexpr size_t WS_W = 0;
constexpr size_t WS_TAB = WS_W + NL * W_LAYER;
constexpr size_t TB_COSB = 0, TB_SINB = 131072, TB_COSD = 262144, TB_SIND = 524288, SZ_TAB = 786432;
constexpr size_t WS_RS0 = WS_TAB + SZ_TAB, WS_RS1 = WS_RS0 + 262144, WS_RSQ = WS_RS1 + 262144, WS_RSKV = WS_RSQ + 262144;
constexpr size_t WS_KPART = WS_RSKV + 262144;
constexpr size_t WS_XB = WS_KPART + 524288;
constexpr size_t WS_P = WS_XB + (size_t)T * DM * 2;
constexpr size_t BUFB = 256ull * 256 * 2, PSTRIDE = 10 * BUFB;
constexpr size_t WS_U = WS_P + NPANEL * PSTRIDE;
constexpr size_t USTRIDE = PSTRIDE;
constexpr size_t WS_BAR = WS_U + NPANEL * USTRIDE;
constexpr size_t WS_END = WS_BAR + 16384;
constexpr size_t U_QD = 0, U_KD = 196608, U_VD = 327680;
constexpr size_t U_G = 0, U_M = 524288, U_MERGED = 786432;
enum { B_AU = 0, B_BQ = 1, B_CB = 2, B_CQ = 3, B_AV = 4, B_BK = 5, B_BV = 6, B_CC = 7, B_CX = 8, B_CKV = 9 };

constexpr int RING_BYTES = 131072, LDS_BYTES = 147456;

DI int opaque_tid() { int t = threadIdx.x; asm volatile("" : "+v"(t)); return t; }
DI unsigned cvtpk(float lo, float hi) { f32x2 v = {lo, hi}; bf16x2_t b = __builtin_convertvector(v, bf16x2_t); return __builtin_bit_cast(unsigned, b); }
DI float bf2f(short s) { return __uint_as_float(((unsigned)(unsigned short)s) << 16); }
DI float wave_sum(float v) {
#pragma unroll
    for (int o = 1; o < 64; o <<= 1) v += __shfl_xor(v, o);
    return v;
}
DI float gelu_tanh(float v) {
    const float z = 0.7978845608028654f * (v + 0.044715f * v * v * v);
    return v * __builtin_amdgcn_rcpf(1.f + __builtin_amdgcn_exp2f(-2.f * LOG2E * z));
}
DI float sigmoidf_(float v) { return __builtin_amdgcn_rcpf(1.f + __builtin_amdgcn_exp2f(-LOG2E * v)); }

namespace pg8 {
constexpr int BM = 256, BK = 64, HALF = 128, HTB = HALF * BK * 2;
DI int lds_byte(int r, int c) { const int st = (r >> 4) * 2 + (c >> 5), rr = r & 15, cc = c & 31, ob = rr * 64 + cc * 2; return st * 1024 + (ob ^ (((ob >> 9) & 1) << 5)); }
DI void stage_rc(int b, int& R, int& C) { const int st = b / 1024, sb = b % 1024, swz = sb ^ (((sb >> 9) & 1) << 5); R = (st >> 1) * 16 + swz / 64; C = (st & 1) * 32 + (swz % 64) / 2; }
DI int perm32(int rho) { const int n = rho >> 4, i = rho & 15; return 8 * (i >> 2) + 4 * n + (i & 3); }
struct Unit { int pm, pn; };
struct Gemm { const bf16_t* A; const bf16_t* Bt; int lda, ldb, K; size_t astride; };
struct Seq { int n, q0, qs, nper, pm0, pmpl, pmr, pn0, pnpl, pnr;
    DI bool next(int i, Unit& u) const { if (i >= n) return false; const int q = q0 + i * qs, pl = q / nper, r = q - pl * nper;
        u.pm = pm0 + pl * pmpl + r * pmr; u.pn = pn0 + pl * pnpl + r * pnr; return true; } };

template <class Epi>
DI void gemm_phase(LAS unsigned char* lds, const Gemm g, const Seq& S_in, const Epi& E) {
    Seq S = S_in; asm volatile("" : "+s"(S.n));
    const int tid = opaque_tid(), wid = __builtin_amdgcn_readfirstlane(tid >> 6), lane = tid & 63, wr = wid >> 2, wc = wid & 3, fr = lane & 15, fq = lane >> 4;
    int K = g.K; asm volatile("" : "+s"(K)); const int nt = K / BK;
    unsigned voffA[2], voffB[2];
#pragma unroll
    for (int i = 0; i < 2; ++i) { int R, C; stage_rc(tid * 16 + i * 8192, R, C); const int Rb = Epi::PERM ? ((R & ~31) + perm32(R & 31)) : R;
        voffA[i] = (unsigned)(R * g.lda + C) * 2u; voffB[i] = (unsigned)(Rb * g.ldb + C) * 2u; }
    const size_t kstep = (size_t)(BK * 2);
    const size_t hstepA = (size_t)HALF * g.lda * 2, hstepB = (size_t)HALF * g.ldb * 2;
    const size_t tstepA = g.astride, tstepB = 2 * hstepB;
    const unsigned ldsw = (unsigned)wid * 1024u;
    const int aoff = lds_byte(wr * 64 + fr, fq * 8), boff = lds_byte(wc * 32 + fr, fq * 8);
#define PG8_SA(b, h) (((b) * 2 + (h)) * HTB)
#define PG8_SB(b, h) ((4 + (b) * 2 + (h)) * HTB)
#define PG8_STAGE(bufoff, gbase, voff) do { _Pragma("unroll") for (int _i = 0; _i < 2; ++_i) \
        __builtin_amdgcn_global_load_lds((const unsigned*)((const char*)(gbase) + (voff)[_i]), (LAS unsigned*)(lds + (bufoff) + ldsw + _i * 8192), 16, 0, 0); } while (0)
#define PG8_LDA(dst, b, h) do { _Pragma("unroll") for (int m = 0; m < 4; ++m) _Pragma("unroll") for (int k = 0; k < 2; ++k) dst[m][k] = *(const LAS bf16x8*)(lds + PG8_SA(b, h) + aoff + m * 2048 + k * 1024); } while (0)
#define PG8_LDB(dst, b, h) do { _Pragma("unroll") for (int n = 0; n < 2; ++n) _Pragma("unroll") for (int k = 0; k < 2; ++k) dst[n][k] = *(const LAS bf16x8*)(lds + PG8_SB(b, h) + boff + n * 2048 + k * 1024); } while (0)
#define PG8_MMA(ai, bj, At, Bt) do { __builtin_amdgcn_s_setprio(1); _Pragma("unroll") for (int m = 0; m < 4; ++m) _Pragma("unroll") for (int n = 0; n < 2; ++n) _Pragma("unroll") for (int k = 0; k < 2; ++k) \
        acc[ai][bj][m][n] = __builtin_amdgcn_mfma_f32_16x16x32_bf16(Bt[n][k], At[m][k], acc[ai][bj][m][n], 0, 0, 0); __builtin_amdgcn_s_setprio(0); } while (0)
#define PG8_WAIT_V(n) asm volatile("s_waitcnt vmcnt(" #n ")" ::: "memory")
#define PG8_WAIT_L(n) asm volatile("s_waitcnt lgkmcnt(" #n ")" ::: "memory")
#define PG8_BAR __builtin_amdgcn_s_barrier()
#define PG8_SCHED __builtin_amdgcn_sched_barrier(0)
    Unit cur, nxt; int ui = 0;
    if (!S.next(0, cur)) return;
    f32x4 acc[2][2][4][2];
#pragma unroll
    for (int a = 0; a < 2; ++a)
#pragma unroll
        for (int b = 0; b < 2; ++b)
#pragma unroll
            for (int m = 0; m < 4; ++m)
#pragma unroll
                for (int n = 0; n < 2; ++n) acc[a][b][m][n] = (f32x4){0.f, 0.f, 0.f, 0.f};
    bf16x8 At[4][2], B0[2][2], B1[2][2];
    const char* cA = (const char*)g.A + (size_t)cur.pm * tstepA; const char* cB = (const char*)g.Bt + (size_t)cur.pn * tstepB;
    PG8_STAGE(PG8_SB(0, 0), cB, voffB); PG8_STAGE(PG8_SB(0, 1), cB + hstepB, voffB); PG8_STAGE(PG8_SA(0, 0), cA, voffA); PG8_STAGE(PG8_SA(0, 1), cA + hstepA, voffA);
    if (wr == 1) PG8_BAR;
    PG8_WAIT_V(2); PG8_BAR;
    PG8_STAGE(PG8_SB(1, 0), cB + kstep, voffB); PG8_STAGE(PG8_SA(1, 0), cA + kstep, voffA); PG8_STAGE(PG8_SB(1, 1), cB + hstepB + kstep, voffB);
    PG8_WAIT_V(6); PG8_BAR;
    for (;;) {
        const bool has_next = S.next(ui + 1, nxt);
        const char* nA = has_next ? (const char*)g.A + (size_t)nxt.pm * tstepA : cA; const char* nB = has_next ? (const char*)g.Bt + (size_t)nxt.pn * tstepB : cB;
#pragma nounroll
        for (int t = 0; t < nt; t += 2) {
            const bool last = (t == nt - 2);
            const char* a1 = cA + (size_t)(t + 1) * kstep;
            const char* a2 = last ? nA : cA + (size_t)(t + 2) * kstep; const char* b2 = last ? nB : cB + (size_t)(t + 2) * kstep;
            const char* a3 = a2 + kstep; const char* b3 = b2 + kstep;
            PG8_LDB(B0, 0, 0); PG8_LDB(B1, 0, 1); PG8_SCHED; PG8_LDA(At, 0, 0); PG8_STAGE(PG8_SA(1, 1), a1 + hstepA, voffA);
            PG8_WAIT_V(8); PG8_WAIT_L(0); PG8_BAR; PG8_MMA(0, 0, At, B0); PG8_MMA(0, 1, At, B1); PG8_BAR; PG8_SCHED;
            PG8_LDA(At, 0, 1); PG8_STAGE(PG8_SB(0, 0), b2, voffB); PG8_STAGE(PG8_SB(0, 1), b2 + hstepB, voffB); PG8_STAGE(PG8_SA(0, 0), a2, voffA);
            PG8_WAIT_V(8); PG8_WAIT_L(0); PG8_BAR; PG8_MMA(1, 0, At, B0); PG8_MMA(1, 1, At, B1); PG8_BAR; PG8_SCHED;
            PG8_LDB(B0, 1, 0); PG8_LDB(B1, 1, 1); PG8_SCHED; PG8_LDA(At, 1, 0); PG8_STAGE(PG8_SA(0, 1), a2 + hstepA, voffA);
            PG8_WAIT_V(8); PG8_WAIT_L(0); PG8_BAR; PG8_MMA(0, 0, At, B0); PG8_MMA(0, 1, At, B1); PG8_BAR; PG8_SCHED;
            PG8_LDA(At, 1, 1); PG8_STAGE(PG8_SB(1, 0), b3, voffB); PG8_STAGE(PG8_SB(1, 1), b3 + hstepB, voffB); PG8_STAGE(PG8_SA(1, 0), a3, voffA);
            PG8_WAIT_V(8); PG8_WAIT_L(0); PG8_BAR; PG8_MMA(1, 0, At, B0); PG8_MMA(1, 1, At, B1); PG8_BAR; PG8_SCHED;
        }
        if (wr == 0) PG8_BAR;
        E(acc, cur, wr, wc, fr, fq);
        if (!has_next) break;
#pragma unroll
        for (int a = 0; a < 2; ++a)
#pragma unroll
            for (int b = 0; b < 2; ++b)
#pragma unroll
                for (int m = 0; m < 4; ++m)
#pragma unroll
                    for (int n = 0; n < 2; ++n) acc[a][b][m][n] = (f32x4){0.f, 0.f, 0.f, 0.f};
        cur = nxt; cA = nA; cB = nB; ++ui;
        if (wr == 1) PG8_BAR;
    }
    PG8_WAIT_V(0);
    PG8_BAR;
#undef PG8_SA
#undef PG8_SB
#undef PG8_STAGE
#undef PG8_LDA
#undef PG8_LDB
#undef PG8_MMA
#undef PG8_WAIT_V
#undef PG8_WAIT_L
#undef PG8_BAR
#undef PG8_SCHED
}
}
using pg8::Unit;
typedef f32x4 Acc[2][2][4][2];

struct EpiInProj {
    static constexpr bool PERM = true;
    unsigned char* Pb_; const float* rs0_; const float* cosb; const float* sinb; const float* cosd; const float* sind; float* kpart_;
    DI void operator()(const Acc& acc, const Unit& u, int wr, int wc, int fr, int fq) const {
        asm volatile("" : "+v"(fr), "+v"(fq));
        const int panel = u.pm; bf16_t* Pp = (bf16_t*)(Pb_ + (size_t)panel * PSTRIDE); const float* rs = rs0_ + panel * 256; float* kpart = kpart_ + (size_t)panel * 512; const int pos0 = (panel & 15) * 256;
        const int tile = u.pn; bf16_t* dst = Pp + (size_t)tile * 65536;
        const bool act = (tile == B_AU) || (tile == B_AV);
        const bool rope16 = ((tile == B_BQ) || (tile == B_BK)) && ((wc & 1) == 0);
        const float qs = (tile == B_BQ) ? C2M : 1.f;
        float csum[2][8];
#pragma unroll
        for (int bj = 0; bj < 2; ++bj)
#pragma unroll
            for (int e = 0; e < 8; ++e) csum[bj][e] = 0.f;
#pragma unroll
        for (int ai = 0; ai < 2; ++ai)
#pragma unroll
            for (int m = 0; m < 4; ++m) {
                const int row = ai * 128 + wr * 64 + m * 16 + fr; const float r = rs[row] * qs; const int pos = pos0 + row;
#pragma unroll
                for (int bj = 0; bj < 2; ++bj) {
                    const int c0 = bj * 128 + wc * 32 + fq * 8;
                    float v[8];
#pragma unroll
                    for (int e = 0; e < 8; ++e) v[e] = acc[ai][bj][m][e >> 2][e & 3] * r;
                    if (act) {
#pragma unroll
                        for (int e = 0; e < 8; ++e) v[e] = gelu_tanh(v[e]);
                    }
                    if (rope16) {
                        const f32x4 ca = *(const f32x4*)(cosb + pos * 8), cb2 = *(const f32x4*)(cosb + pos * 8 + 4);
                        const f32x4 sa = *(const f32x4*)(sinb + pos * 8), sb2 = *(const f32x4*)(sinb + pos * 8 + 4);
#pragma unroll
                        for (int e = 0; e < 8; ++e) { const float o = __shfl_xor(v[e], 16); const float c = e < 4 ? ca[e & 3] : cb2[e & 3], s = e < 4 ? sa[e & 3] : sb2[e & 3];
                            const float rot = (fq == 0) ? (v[e] * c - o * s) : (v[e] * c + o * s); if (fq < 2) v[e] = rot; }
                    }
                    if (tile == B_CKV && bj == 1 && wc == 0) {
                        const int ib = 8 * (fq & 1);
                        const f32x4 ca = *(const f32x4*)(cosd + pos * 16 + ib), cb2 = *(const f32x4*)(cosd + pos * 16 + ib + 4);
                        const f32x4 sa = *(const f32x4*)(sind + pos * 16 + ib), sb2 = *(const f32x4*)(sind + pos * 16 + ib + 4);
#pragma unroll
                        for (int e = 0; e < 8; ++e) { const float o = __shfl_xor(v[e], 32); const float c = e < 4 ? ca[e & 3] : cb2[e & 3], s = e < 4 ? sa[e & 3] : sb2[e & 3];
                            v[e] = (fq < 2) ? (v[e] * c - o * s) : (v[e] * c + o * s); }
                    }
                    if (tile == B_BK) {
#pragma unroll
                        for (int e = 0; e < 8; ++e) csum[bj][e] += v[e];
                    }
                    u32x4 w; w.x = cvtpk(v[0], v[1]); w.y = cvtpk(v[2], v[3]); w.z = cvtpk(v[4], v[5]); w.w = cvtpk(v[6], v[7]);
                    *(u32x4*)(dst + row * 256 + c0) = w;
                }
                asm volatile("" ::: "memory");
            }
        if (tile == B_BK) {
#pragma unroll
            for (int bj = 0; bj < 2; ++bj)
#pragma unroll
                for (int e = 0; e < 8; ++e) { float s = csum[bj][e]; s += __shfl_xor(s, 1); s += __shfl_xor(s, 2); s += __shfl_xor(s, 4); s += __shfl_xor(s, 8);
                    if (fr == 0) kpart[wr * 256 + bj * 128 + wc * 32 + fq * 8 + e] = s; }
        }
    }
};
struct EpiUpQ {
    static constexpr bool PERM = true;
    bf16_t* Qp; const float* rsq; const float* cosd; const float* sind; int pos0;
    DI void operator()(const Acc& acc, const Unit& u, int wr, int wc, int fr, int fq) const {
        asm volatile("" : "+v"(fr), "+v"(fq));
        const int tile = u.pn;
#pragma unroll
        for (int ai = 0; ai < 2; ++ai)
#pragma unroll
            for (int m = 0; m < 4; ++m) {
                const int row = ai * 128 + wr * 64 + m * 16 + fr; const float r = rsq[row] * C2D; const int pos = pos0 + row;
#pragma unroll
                for (int bj = 0; bj < 2; ++bj) {
                    float v[8];
#pragma unroll
                    for (int e = 0; e < 8; ++e) v[e] = acc[ai][bj][m][e >> 2][e & 3] * r;
                    if (tile == 0) {
                        const int c0 = bj * 128 + wc * 32 + fq * 8, head = c0 >> 6, e0 = c0 & 63;
                        u32x4 w; w.x = cvtpk(v[0], v[1]); w.y = cvtpk(v[2], v[3]); w.z = cvtpk(v[4], v[5]); w.w = cvtpk(v[6], v[7]);
                        *(u32x4*)(Qp + row * 384 + head * 96 + e0) = w;
                    } else if (bj == 0) {
                        const int ib = 8 * (fq & 1);
                        const f32x4 ca = *(const f32x4*)(cosd + pos * 16 + ib), cb2 = *(const f32x4*)(cosd + pos * 16 + ib + 4);
                        const f32x4 sa = *(const f32x4*)(sind + pos * 16 + ib), sb2 = *(const f32x4*)(sind + pos * 16 + ib + 4);
#pragma unroll
                        for (int e = 0; e < 8; ++e) { const float o = __shfl_xor(v[e], 32); const float c = e < 4 ? ca[e & 3] : cb2[e & 3], s = e < 4 ? sa[e & 3] : sb2[e & 3];
                            v[e] = (fq < 2) ? (v[e] * c - o * s) : (v[e] * c + o * s); }
                        u32x4 w; w.x = cvtpk(v[0], v[1]); w.y = cvtpk(v[2], v[3]); w.z = cvtpk(v[4], v[5]); w.w = cvtpk(v[6], v[7]);
                        *(u32x4*)(Qp + row * 384 + wc * 96 + 64 + fq * 8) = w;
                    }
                }
                asm volatile("" ::: "memory");
            }
    }
};
struct EpiUpKV {
    static constexpr bool PERM = true;
    bf16_t* Kp; bf16_t* Vp; const float* rskv;
    DI void operator()(const Acc& acc, const Unit& u, int wr, int wc, int fr, int fq) const {
        asm volatile("" : "+v"(fr), "+v"(fq));
        bf16_t* dst = u.pn == 0 ? Kp : Vp;
#pragma unroll
        for (int ai = 0; ai < 2; ++ai)
#pragma unroll
            for (int m = 0; m < 4; ++m) {
                const int row = ai * 128 + wr * 64 + m * 16 + fr; const float r = rskv[row];
#pragma unroll
                for (int bj = 0; bj < 2; ++bj) {
                    const int c0 = bj * 128 + wc * 32 + fq * 8; float v[8];
#pragma unroll
                    for (int e = 0; e < 8; ++e) v[e] = acc[ai][bj][m][e >> 2][e & 3] * r;
                    u32x4 w; w.x = cvtpk(v[0], v[1]); w.y = cvtpk(v[2], v[3]); w.z = cvtpk(v[4], v[5]); w.w = cvtpk(v[6], v[7]);
                    *(u32x4*)(dst + row * 256 + c0) = w;
                }
                asm volatile("" ::: "memory");
            }
    }
};
struct EpiG {
    static constexpr bool PERM = true;
    unsigned char* Gs; const float* rs;
    DI void operator()(const Acc& acc, const Unit& u, int wr, int wc, int fr, int fq) const {
        asm volatile("" : "+v"(fr), "+v"(fq));
        const int br = u.pn >> 2; u32x4* g = (u32x4*)(Gs + (size_t)br * 131072) + opaque_tid();
#pragma unroll
        for (int ai = 0; ai < 2; ++ai)
#pragma unroll
            for (int m = 0; m < 4; ++m) {
                const int row = ai * 128 + wr * 64 + m * 16 + fr; const float r = rs[row];
#pragma unroll
                for (int bj = 0; bj < 2; ++bj) {
                    float v[8];
#pragma unroll
                    for (int e = 0; e < 8; ++e) v[e] = sigmoidf_(acc[ai][bj][m][e >> 2][e & 3] * r);
                    u32x4 w; w.x = cvtpk(v[0], v[1]); w.y = cvtpk(v[2], v[3]); w.z = cvtpk(v[4], v[5]); w.w = cvtpk(v[6], v[7]);
                    g[((ai * 2 + bj) * 4 + m) * 512] = w;
                }
                asm volatile("" ::: "memory");
            }
    }
};
struct EpiY {
    static constexpr bool PERM = true;
    unsigned char* Gs; unsigned char* Ms; bf16_t* merged; int pnn; int brbase;
    DI void operator()(const Acc& acc, const Unit& u, int wr, int wc, int fr, int fq) const {
        asm volatile("" : "+v"(fr), "+v"(fq));
        const int br = u.pm - brbase; const int tq = opaque_tid(); const u32x4* g = (const u32x4*)(Gs + (size_t)br * 131072) + tq; f32x4* ms = (f32x4*)Ms + tq;
#pragma unroll
        for (int ai = 0; ai < 2; ++ai)
#pragma unroll
            for (int m = 0; m < 4; ++m) {
                const int row = ai * 128 + wr * 64 + m * 16 + fr;
#pragma unroll
                for (int bj = 0; bj < 2; ++bj) {
                    const int k = (ai * 2 + bj) * 4 + m; const u32x4 gw = g[k * 512];
                    float gt[8]; gt[0] = __uint_as_float(gw.x << 16); gt[1] = __uint_as_float(gw.x & 0xffff0000u); gt[2] = __uint_as_float(gw.y << 16); gt[3] = __uint_as_float(gw.y & 0xffff0000u);
                    gt[4] = __uint_as_float(gw.z << 16); gt[5] = __uint_as_float(gw.z & 0xffff0000u); gt[6] = __uint_as_float(gw.w << 16); gt[7] = __uint_as_float(gw.w & 0xffff0000u);
                    f32x4 v0, v1;
#pragma unroll
                    for (int e = 0; e < 4; ++e) { v0[e] = acc[ai][bj][m][0][e] * gt[e]; v1[e] = acc[ai][bj][m][1][e] * gt[4 + e]; }
                    if (br > 0) { v0 += ms[(2 * k) * 512]; v1 += ms[(2 * k + 1) * 512]; }
                    if (br < 3) { ms[(2 * k) * 512] = v0; ms[(2 * k + 1) * 512] = v1; }
                    else { const int c0 = pnn * 256 + bj * 128 + wc * 32 + fq * 8;
                        u32x4 w; w.x = cvtpk(v0[0], v0[1]); w.y = cvtpk(v0[2], v0[3]); w.z = cvtpk(v1[0], v1[1]); w.w = cvtpk(v1[2], v1[3]);
                        *(u32x4*)(merged + row * 1024 + c0) = w; }
                }
                asm volatile("" ::: "memory");
            }
    }
};
struct EpiF32 {
    static constexpr bool PERM = false;
    float* Yb; int accum;
    DI void operator()(const Acc& acc, const Unit& u, int wr, int wc, int fr, int fq) const {
        asm volatile("" : "+v"(fr), "+v"(fq));
        float* Y = Yb + (size_t)u.pm * (PSTRIDE / 4);
#pragma unroll
        for (int ai = 0; ai < 2; ++ai)
#pragma unroll
            for (int m = 0; m < 4; ++m) {
                const int row = ai * 128 + wr * 64 + m * 16 + fr;
#pragma unroll
                for (int bj = 0; bj < 2; ++bj)
#pragma unroll
                    for (int n = 0; n < 2; ++n) { f32x4* p = (f32x4*)(Y + row * 1024 + u.pn * 256 + bj * 128 + wc * 32 + n * 16 + fq * 4);
                        f32x4 v = acc[ai][bj][m][n]; if (accum) v += *p; *p = v; }
                asm volatile("" ::: "memory");
            }
    }
};
struct EpiMlpIn {
    static constexpr bool PERM = true;
    unsigned char* Ub_; const float* rs1_; int pn_base;
    DI void operator()(const Acc& acc, const Unit& u, int wr, int wc, int fr, int fq) const {
        asm volatile("" : "+v"(fr), "+v"(fq));
        bf16_t* Uo = (bf16_t*)(Ub_ + (size_t)u.pm * USTRIDE); const float* rs = rs1_ + u.pm * 256;
        const int ct = (u.pn - pn_base) * 256;
#pragma unroll
        for (int ai = 0; ai < 2; ++ai)
#pragma unroll
            for (int m = 0; m < 4; ++m) {
                const int row = ai * 128 + wr * 64 + m * 16 + fr; const float r = rs[row];
#pragma unroll
                for (int bj = 0; bj < 2; ++bj) {
                    const int c0 = ct + bj * 128 + wc * 32 + fq * 8; float v[8];
#pragma unroll
                    for (int e = 0; e < 8; ++e) { const float t = fmaxf(acc[ai][bj][m][e >> 2][e & 3] * r, 0.f); v[e] = t * t; }
                    u32x4 w; w.x = cvtpk(v[0], v[1]); w.y = cvtpk(v[2], v[3]); w.z = cvtpk(v[4], v[5]); w.w = cvtpk(v[6], v[7]);
                    *(u32x4*)(Uo + row * 2048 + c0) = w;
                }
                asm volatile("" ::: "memory");
            }
    }
};

DI int crow(int r, int hi) { return (r & 3) + 8 * (r >> 2) + 4 * hi; }
#define MFMA32(a, b, c) __builtin_amdgcn_mfma_f32_32x32x16_bf16((a), (b), (c), 0, 0, 0)
template <int DQK, bool MOBA>
DI void attn_unit(int b, int h, int qb, unsigned char* P, unsigned char* U, const float* kpart, LAS unsigned char* lds, int obuf) {
    constexpr int ND0 = DQK / 16, KSTR = DQK * 2 + 16, VSTR = 144;
    constexpr int L_K = 0, L_V = 13312, L_KM = 22528;
    constexpr float NEG = -1e30f;
    const int tid = opaque_tid(), lane = tid & 63, wid = __builtin_amdgcn_readfirstlane(tid >> 6), r = lane & 31, hh = lane >> 5;
    const int panel_q = b * 16 + qb;
    unsigned char* Pq = P + (size_t)panel_q * PSTRIDE; unsigned char* Uq = U + (size_t)panel_q * USTRIDE;
    const bf16_t* qrow = MOBA ? (const bf16_t*)(Pq + B_BQ * BUFB) + (32 * wid + r) * 256 + h * 64 : (const bf16_t*)(Uq + U_QD) + (32 * wid + r) * 384 + h * 96;
    bf16x8 qf[ND0];
#pragma unroll
    for (int d0 = 0; d0 < ND0; ++d0) qf[d0] = *(const bf16x8*)(qrow + 16 * d0 + 8 * hh);
    unsigned mask = 0xffffffffu;
    if (MOBA) {
        LAS float* km = (LAS float*)(lds + L_KM);
        __syncthreads();
        for (int idx = tid; idx < qb * 64; idx += 512) { const int n = idx >> 6, d = idx & 63; const float* kp = kpart + (size_t)(b * 16 + n) * 512 + h * 64 + d; km[idx] = (kp[0] + kp[256]) * (1.f / 256.f); }
        __syncthreads();
        if (qb <= 3) mask = (1u << qb) - 1u;
        else {
            float qv[ND0 * 8];
#pragma unroll
            for (int d0 = 0; d0 < ND0; ++d0)
#pragma unroll
                for (int j = 0; j < 8; ++j) qv[d0 * 8 + j] = bf2f(qf[d0][j]);
            float v1 = -INFINITY, v2 = -INFINITY, v3 = -INFINITY; int i1 = -1, i2 = -1, i3 = -1;
            for (int n = 0; n < qb; ++n) {
                float g = 0.f;
#pragma unroll
                for (int d0 = 0; d0 < ND0; ++d0)
#pragma unroll
                    for (int j = 0; j < 8; ++j) g += qv[d0 * 8 + j] * km[n * 64 + 16 * d0 + 8 * hh + j];
                g += __shfl_xor(g, 32);
                if (g > v1) { v3 = v2; i3 = i2; v2 = v1; i2 = i1; v1 = g; i1 = n; }
                else if (g > v2) { v3 = v2; i3 = i2; v2 = g; i2 = n; }
                else if (g > v3) { v3 = g; i3 = n; }
            }
            mask = (1u << i1) | (1u << i2) | (1u << i3);
        }
    }
    const int NT = 4 * (qb + 1);
    const int lkey = tid >> 3, lch = tid & 7;
    u32x4 kreg, vreg, kreg2 = (u32x4){0u, 0u, 0u, 0u};
#define ATT_LOAD(kt) do { const int kp_ = b * 16 + ((kt) >> 2), r0_ = 64 * ((kt) & 3); \
        const unsigned char* Pk_ = P + (size_t)kp_ * PSTRIDE; const unsigned char* Uk_ = U + (size_t)kp_ * USTRIDE; \
        const bf16_t* ks_ = MOBA ? (const bf16_t*)(Pk_ + B_BK * BUFB) : (const bf16_t*)(Uk_ + U_KD); \
        const bf16_t* vs_ = MOBA ? (const bf16_t*)(Pk_ + B_BV * BUFB) : (const bf16_t*)(Uk_ + U_VD); \
        kreg = *(const u32x4*)(ks_ + (r0_ + lkey) * 256 + h * 64 + 8 * lch); \
        vreg = *(const u32x4*)(vs_ + (r0_ + lkey) * 256 + h * 64 + 8 * lch); \
        if (!MOBA && tid < 256) kreg2 = *(const u32x4*)((const bf16_t*)(Pk_ + B_CKV * BUFB) + (r0_ + (tid >> 2)) * 256 + 128 + 8 * (tid & 3)); } while (0)
    float mrun = NEG, lrun = 0.f;
    f32x16 o0, o1;
#pragma unroll
    for (int i = 0; i < 16; ++i) { o0[i] = 0.f; o1[i] = 0.f; }
    ATT_LOAD(0);
    for (int kt = 0; kt < NT; ++kt) {
        __syncthreads();
        *(LAS u32x4*)(lds + L_K + lkey * KSTR + lch * 16) = kreg;
        if (!MOBA && tid < 256) *(LAS u32x4*)(lds + L_K + (tid >> 2) * KSTR + 128 + (tid & 3) * 16) = kreg2;
        {
            LAS unsigned short* vt = (LAS unsigned short*)(lds + L_V + (8 * lch) * VSTR + lkey * 2);
            vt[0 * (VSTR / 2)] = (unsigned short)(vreg.x & 0xffffu); vt[1 * (VSTR / 2)] = (unsigned short)(vreg.x >> 16);
            vt[2 * (VSTR / 2)] = (unsigned short)(vreg.y & 0xffffu); vt[3 * (VSTR / 2)] = (unsigned short)(vreg.y >> 16);
            vt[4 * (VSTR / 2)] = (unsigned short)(vreg.z & 0xffffu); vt[5 * (VSTR / 2)] = (unsigned short)(vreg.z >> 16);
            vt[6 * (VSTR / 2)] = (unsigned short)(vreg.w & 0xffffu); vt[7 * (VSTR / 2)] = (unsigned short)(vreg.w >> 16);
        }
        __syncthreads();
        if (kt + 1 < NT) ATT_LOAD(kt + 1);
        const int nblk = kt >> 2; const bool diag = (nblk == qb); const int kr0 = 64 * (kt & 3);
        if (diag && kr0 > 32 * wid + 31) continue;
        bool lane_sel = true;
        if (MOBA && !diag) { lane_sel = ((mask >> nblk) & 1u) != 0u; if (!__any(lane_sel)) continue; }
        f32x16 p0, p1;
#pragma unroll
        for (int i = 0; i < 16; ++i) { p0[i] = 0.f; p1[i] = 0.f; }
#pragma unroll
        for (int d0 = 0; d0 < ND0; ++d0) {
            const bf16x8 a0 = *(const LAS bf16x8*)(lds + L_K + r * KSTR + (16 * d0 + 8 * hh) * 2);
            const bf16x8 a1 = *(const LAS bf16x8*)(lds + L_K + (32 + r) * KSTR + (16 * d0 + 8 * hh) * 2);
            p0 = MFMA32(a0, qf[d0], p0); p1 = MFMA32(a1, qf[d0], p1);
        }
        if (diag) { const int qr = 32 * wid + r;
#pragma unroll
            for (int i = 0; i < 16; ++i) { const int kk = kr0 + crow(i, hh); if (kk > qr) p0[i] = NEG; if (kk + 32 > qr) p1[i] = NEG; } }
        if (MOBA && !diag && !lane_sel) {
#pragma unroll
            for (int i = 0; i < 16; ++i) { p0[i] = NEG; p1[i] = NEG; } }
        float mx = fmaxf(p0[0], p1[0]);
#pragma unroll
        for (int i = 1; i < 16; ++i) mx = fmaxf(mx, fmaxf(p0[i], p1[i]));
        mx = fmaxf(mx, __shfl_xor(mx, 32));
        const float mnew = fmaxf(mrun, mx), alpha = __builtin_amdgcn_exp2f(mrun - mnew); mrun = mnew;
        float ps = 0.f;
#pragma unroll
        for (int i = 0; i < 16; ++i) { p0[i] = __builtin_amdgcn_exp2f(p0[i] - mnew); p1[i] = __builtin_amdgcn_exp2f(p1[i] - mnew); ps += p0[i] + p1[i]; }
        lrun = lrun * alpha + ps;
#pragma unroll
        for (int i = 0; i < 16; ++i) { o0[i] *= alpha; o1[i] *= alpha; }
#pragma unroll
        for (int kh = 0; kh < 2; ++kh)
#pragma unroll
            for (int s = 0; s < 2; ++s) {
                u32x4 pw;
                if (kh == 0) { pw.x = cvtpk(p0[8 * s], p0[8 * s + 1]); pw.y = cvtpk(p0[8 * s + 2], p0[8 * s + 3]); pw.z = cvtpk(p0[8 * s + 4], p0[8 * s + 5]); pw.w = cvtpk(p0[8 * s + 6], p0[8 * s + 7]); }
                else { pw.x = cvtpk(p1[8 * s], p1[8 * s + 1]); pw.y = cvtpk(p1[8 * s + 2], p1[8 * s + 3]); pw.z = cvtpk(p1[8 * s + 4], p1[8 * s + 5]); pw.w = cvtpk(p1[8 * s + 6], p1[8 * s + 7]); }
                const bf16x8 pf = __builtin_bit_cast(bf16x8, pw);
                const int kb = (32 * kh + 16 * s + 4 * hh) * 2;
                {   const u32x2 lo = *(const LAS u32x2*)(lds + L_V + r * VSTR + kb), hi = *(const LAS u32x2*)(lds + L_V + r * VSTR + kb + 16);
                    const u32x4 vv = (u32x4){lo.x, lo.y, hi.x, hi.y}; o0 = MFMA32(__builtin_bit_cast(bf16x8, vv), pf, o0); }
                {   const u32x2 lo = *(const LAS u32x2*)(lds + L_V + (32 + r) * VSTR + kb), hi = *(const LAS u32x2*)(lds + L_V + (32 + r) * VSTR + kb + 16);
                    const u32x4 vv = (u32x4){lo.x, lo.y, hi.x, hi.y}; o1 = MFMA32(__builtin_bit_cast(bf16x8, vv), pf, o1); }
            }
    }
#undef ATT_LOAD
    lrun += __shfl_xor(lrun, 32);
    const float rl = 1.f / lrun;
    bf16_t* orow = (bf16_t*)(Pq + (size_t)obuf * BUFB) + (32 * wid + r) * 256 + h * 64;
#pragma unroll
    for (int g4 = 0; g4 < 4; ++g4) {
        u32x2 w0, w1;
        w0.x = cvtpk(o0[4 * g4] * rl, o0[4 * g4 + 1] * rl); w0.y = cvtpk(o0[4 * g4 + 2] * rl, o0[4 * g4 + 3] * rl);
        w1.x = cvtpk(o1[4 * g4] * rl, o1[4 * g4 + 1] * rl); w1.y = cvtpk(o1[4 * g4 + 2] * rl, o1[4 * g4 + 3] * rl);
        *(u32x2*)(orow + 8 * g4 + 4 * hh) = w0; *(u32x2*)(orow + 32 + 8 * g4 + 4 * hh) = w1;
    }
}

struct Params {
    const float* x; const float* g_pre_mix; const float* w_in; const float* a_ln_g; const float* a_ln_b; const float* a_w_s; const float* a_b_s; const float* c_w_conv;
    const float* d_q_norm_g; const float* d_w_uq; const float* d_kv_norm_g; const float* d_w_ukv; const float* w_branch; const float* w_out; const float* g_post_mix;
    const float* g_pre_mlp; const float* w_mlp_in; const float* w_mlp_out; const float* g_post_mlp;
    float* out; unsigned char* ws;
    float invb[8]; float invd[16];
};

DI void norm_step(const float* y, const float* xsrc, float* xdst, bf16_t* xb, float* rs_out, const float* gain, int wid, int lane_) {
    int lane = lane_; asm volatile("" : "+v"(lane));
    f32x4 gv[4];
#pragma unroll
    for (int j = 0; j < 4; ++j) gv[j] = *(const f32x4*)(gain + 4 * lane + 256 * j);
    for (int rr = 0; rr < 32; rr += 4) {
        f32x4 yv[4][4], xv[4][4];
#pragma unroll
        for (int q = 0; q < 4; ++q)
#pragma unroll
            for (int j = 0; j < 4; ++j) { const int row = wid * 32 + rr + q; yv[q][j] = *(const f32x4*)(y + row * 1024 + 4 * lane + 256 * j); xv[q][j] = *(const f32x4*)(xsrc + (size_t)row * 1024 + 4 * lane + 256 * j); }
#pragma unroll
        for (int q = 0; q < 4; ++q) {
            const int row = wid * 32 + rr + q; float ss = 0.f;
#pragma unroll
            for (int j = 0; j < 4; ++j) ss += yv[q][j].x * yv[q][j].x + yv[q][j].y * yv[q][j].y + yv[q][j].z * yv[q][j].z + yv[q][j].w * yv[q][j].w;
            const float ry = 1.0f / sqrtf(wave_sum(ss) * (1.f / 1024.f) + EPS); float s2 = 0.f;
#pragma unroll
            for (int j = 0; j < 4; ++j) { const f32x4 xn = xv[q][j] + yv[q][j] * ry * gv[j];
                *(f32x4*)(xdst + (size_t)row * 1024 + 4 * lane + 256 * j) = xn; s2 += xn.x * xn.x + xn.y * xn.y + xn.z * xn.z + xn.w * xn.w;
                u32x2 w; w.x = cvtpk(xn.x, xn.y); w.y = cvtpk(xn.z, xn.w); *(u32x2*)(xb + (size_t)row * 1024 + 4 * lane + 256 * j) = w; }
            s2 = wave_sum(s2);
            if (lane == 0) rs_out[row] = 1.0f / sqrtf(s2 * (1.f / 1024.f) + EPS);
        }
    }
}
DI void prep_panel(const float* xsrc, bf16_t* xb, float* rs_out, int wid, int lane_) {
    int lane = lane_; asm volatile("" : "+v"(lane));
    for (int rr = 0; rr < 32; rr += 4) {
        f32x4 xv[4][4];
#pragma unroll
        for (int q = 0; q < 4; ++q)
#pragma unroll
            for (int j = 0; j < 4; ++j) xv[q][j] = *(const f32x4*)(xsrc + (size_t)(wid * 32 + rr + q) * 1024 + 4 * lane + 256 * j);
#pragma unroll
        for (int q = 0; q < 4; ++q) {
            const int row = wid * 32 + rr + q; float s2 = 0.f;
#pragma unroll
            for (int j = 0; j < 4; ++j) { const f32x4 xn = xv[q][j]; s2 += xn.x * xn.x + xn.y * xn.y + xn.z * xn.z + xn.w * xn.w;
                u32x2 w; w.x = cvtpk(xn.x, xn.y); w.y = cvtpk(xn.z, xn.w); *(u32x2*)(xb + (size_t)row * 1024 + 4 * lane + 256 * j) = w; }
            s2 = wave_sum(s2);
            if (lane == 0) rs_out[row] = 1.0f / sqrtf(s2 * (1.f / 1024.f) + EPS);
        }
    }
}
struct TJob { const float* src; int src_ld, src_col0, nvalid, ksrc; bf16_t* dst; int ndst, kdst; const float* g; };
DI TJob get_job(const Params& p, int l, int j) {
    unsigned char* wl = p.ws + WS_W + (size_t)l * W_LAYER; TJob t;
    const float* win = p.w_in + (size_t)l * DM * INC;
    if (j < 10) {
        const int st[10] = {0, 512, 1280, 2048, 256, 768, 1024, 1536, 1792, 2240}; const int nv[10] = {256, 256, 256, 192, 256, 256, 256, 256, 256, 160};
        int s0 = 0, n0 = 0;
#pragma unroll
        for (int q = 0; q < 10; ++q) if (q == j) { s0 = st[q]; n0 = nv[q]; }
        t = TJob{win, INC, s0, n0, 1024, (bf16_t*)(wl + OW_IN) + (size_t)j * 256 * 1024, 256, 1024, p.g_pre_mix + l * DM};
    } else if (j == 10) t = TJob{win, INC, 2400, 4096, 1024, (bf16_t*)(wl + OW_G), 4096, 1024, p.g_pre_mix + l * DM};
    else if (j < 15) { const int i = j - 11; t = TJob{p.w_branch + ((size_t)l * 4 + i) * 256 * 1024, 1024, 0, 1024, 256, (bf16_t*)(wl + OW_B) + (size_t)i * 1024 * 256, 1024, 256, nullptr}; }
    else if (j == 15) t = TJob{p.w_out + (size_t)l * DM * DM, 1024, 0, 1024, 1024, (bf16_t*)(wl + OW_OUT), 1024, 1024, nullptr};
    else if (j == 16) t = TJob{p.w_mlp_in + (size_t)l * DM * DFF, DFF, 0, 4096, 1024, (bf16_t*)(wl + OW_1), 4096, 1024, p.g_pre_mlp + l * DM};
    else if (j == 17) t = TJob{p.w_mlp_out + (size_t)l * DFF * DM, 1024, 0, 1024, 4096, (bf16_t*)(wl + OW_2), 1024, 4096, nullptr};
    else if (j < 22) { const int h = j - 18; t = TJob{p.d_w_uq + (size_t)l * 192 * 384, 384, h * 96, 64, 192, (bf16_t*)(wl + OW_UQ) + (size_t)(h * 64) * 256, 64, 256, p.d_q_norm_g + l * 192}; }
    else if (j < 26) { const int h = j - 22; t = TJob{p.d_w_uq + (size_t)l * 192 * 384, 384, h * 96 + 64, 32, 192, (bf16_t*)(wl + OW_UQ) + (size_t)(256 + h * 32) * 256, 32, 256, p.d_q_norm_g + l * 192}; }
    else if (j == 26) t = TJob{p.d_w_uq, 384, 0, 0, 0, (bf16_t*)(wl + OW_UQ) + (size_t)384 * 256, 128, 256, nullptr};
    else if (j < 31) { const int h = j - 27; t = TJob{p.d_w_ukv + (size_t)l * 128 * 512, 512, h * 128, 64, 128, (bf16_t*)(wl + OW_UKV) + (size_t)(h * 64) * 128, 64, 128, p.d_kv_norm_g + l * 128}; }
    else { const int h = j - 31; t = TJob{p.d_w_ukv + (size_t)l * 128 * 512, 512, h * 128 + 64, 64, 128, (bf16_t*)(wl + OW_UKV) + (size_t)(256 + h * 64) * 128, 64, 128, p.d_kv_norm_g + l * 128}; }
    return t;
}
DI void transpose_item(const TJob& t, LAS float* scr, int item, int lane) {
    const int nn = t.ndst / 32, kb = item / nn, nb = item % nn, k0 = 64 * kb, n0 = 32 * nb;
    const bool valid = (k0 < t.ksrc) && (n0 < t.nvalid);
    const int c = lane & 7;
    if (valid) {
        float v[32];
        const float* sp = t.src + (size_t)(k0 + (lane >> 5)) * t.src_ld + t.src_col0 + n0 + (lane & 31);
#pragma unroll
        for (int i = 0; i < 32; ++i) v[i] = sp[(size_t)(2 * i) * t.src_ld];
        f32x4 g0 = (f32x4){1.f, 1.f, 1.f, 1.f}, g1 = g0;
        if (t.g) { g0 = *(const f32x4*)(t.g + k0 + 8 * c); g1 = *(const f32x4*)(t.g + k0 + 8 * c + 4); }
#pragma unroll
        for (int i = 0; i < 32; ++i) scr[(2 * i + (lane >> 5)) * 33 + (lane & 31)] = v[i];
        asm volatile("s_waitcnt lgkmcnt(0)" ::: "memory");
#pragma unroll
        for (int j = 0; j < 4; ++j) { const int n = (lane >> 3) + 8 * j; const LAS float* s = scr + (8 * c) * 33 + n;
            u32x4 o; o.x = cvtpk(s[0 * 33] * g0[0], s[1 * 33] * g0[1]); o.y = cvtpk(s[2 * 33] * g0[2], s[3 * 33] * g0[3]); o.z = cvtpk(s[4 * 33] * g1[0], s[5 * 33] * g1[1]); o.w = cvtpk(s[6 * 33] * g1[2], s[7 * 33] * g1[3]);
            *(u32x4*)(t.dst + (size_t)(n0 + n) * t.kdst + k0 + 8 * c) = o; }
        asm volatile("s_waitcnt lgkmcnt(0)" ::: "memory");
    } else {
#pragma unroll
        for (int j = 0; j < 4; ++j) { const int n = (lane >> 3) + 8 * j; *(u32x4*)(t.dst + (size_t)(n0 + n) * t.kdst + k0 + 8 * c) = (u32x4){0u, 0u, 0u, 0u}; }
    }
}
DI void sincos_d(float af, float& s_out, float& c_out) {
    const double a = (double)af; const double q = rint(a * 0.63661977236758134308);
    double r = fma(-q, 1.57079632679489655800e+00, a); r = fma(-q, 6.12323399573676603587e-17, r);
    const double r2 = r * r;
    double sp = -7.6471637318198164759e-13; sp = fma(sp, r2, 1.6059043836821614599e-10); sp = fma(sp, r2, -2.5052108385441718775e-08); sp = fma(sp, r2, 2.7557319223985890653e-06);
    sp = fma(sp, r2, -1.9841269841269841270e-04); sp = fma(sp, r2, 8.3333333333333333333e-03); sp = fma(sp, r2, -1.6666666666666666667e-01); const double sn = fma(sp * r2, r, r);
    double cp = 4.7794773323873852974e-14; cp = fma(cp, r2, -1.1470745597729724714e-11); cp = fma(cp, r2, 2.0876756987868098979e-09); cp = fma(cp, r2, -2.7557319223985890653e-07);
    cp = fma(cp, r2, 2.4801587301587301587e-05); cp = fma(cp, r2, -1.3888888888888888889e-03); cp = fma(cp, r2, 4.1666666666666666667e-02); cp = fma(cp, r2, -0.5); const double cs = fma(cp, r2, 1.0);
    const int qi = ((int)q) & 3;
    const double s = (qi == 0) ? sn : (qi == 1) ? cs : (qi == 2) ? -sn : -cs;
    const double c = (qi == 0) ? cs : (qi == 1) ? -sn : (qi == 2) ? -cs : sn;
    s_out = (float)s; c_out = (float)c;
}

#define XB_TMO      128
#define XB_XCNT(j)  (256  + 64 * (j))
#define XB_XSUB(j)  (1280 + 64 * (j))
#define XB_XGEN(j)  (2304 + 64 * (j))
#define XB_TOP      3328
#define XB_TOPGEN   3392
#define XCD_BAR_WORDS 3456
#define XB_SPIN_CAP (1u << 18)

__device__ __forceinline__ unsigned xb_ld(unsigned* p)              { return __hip_atomic_load(p, __ATOMIC_RELAXED, __HIP_MEMORY_SCOPE_AGENT); }
__device__ __forceinline__ unsigned xb_add(unsigned* p, unsigned v) { return __hip_atomic_fetch_add(p, v, __ATOMIC_RELAXED, __HIP_MEMORY_SCOPE_AGENT); }
__device__ __forceinline__ unsigned xb_xcc_id() { return (unsigned)__builtin_amdgcn_s_getreg((3 << 11) | 20) & 0xFu; }
#define XB_SPIN(cond, bar) do { unsigned _sp = 0; while (cond) { __builtin_amdgcn_s_sleep(1); \
    if ((++_sp & 255u) == 0u) { if (xb_ld(&(bar)[XB_TMO])) break; if (_sp > XB_SPIN_CAP) { atomicAdd(&(bar)[XB_TMO], 1u); break; } } } } while (0)

struct XcdBarrier {
    unsigned* bar; unsigned x;
    volatile LAS unsigned* st;
};

__device__ __forceinline__ XcdBarrier xcd_barrier_post(unsigned* bar, volatile LAS unsigned* st) {
    XcdBarrier b; b.bar = bar; b.x = xb_xcc_id(); b.st = st;
    if (threadIdx.x == 0) (void)xb_add(&bar[XB_XCNT(b.x)], 1u);
    return b;
}
__device__ __forceinline__ void xcd_barrier_complete(unsigned* bar, unsigned x, unsigned& nloc, unsigned& nx) {
    const unsigned G = gridDim.x * gridDim.y * gridDim.z;
    unsigned sum, cnt, mine, sp = 0u;
    for (;;) {
        sum = 0u; cnt = 0u; mine = 0u;
#pragma unroll
        for (unsigned j = 0; j < 16; ++j) { const unsigned c = xb_ld(&bar[XB_XCNT(j)]); sum += c; cnt += (c > 0u) ? 1u : 0u; mine = (j == x) ? c : mine; }
        if (sum == G) break;
        __builtin_amdgcn_s_sleep(1);
        if ((++sp & 255u) == 0u) { if (xb_ld(&bar[XB_TMO])) break; if (sp > XB_SPIN_CAP) { atomicAdd(&bar[XB_TMO], 1u); break; } }
    }
    nloc = mine > 0u ? mine : 1u; nx = cnt > 0u ? cnt : 1u;
}

__device__ __forceinline__ void xcd_barrier(const XcdBarrier& b) {
    asm volatile("s_waitcnt vmcnt(0)" ::: "memory");
    __syncthreads();
    if (threadIdx.x == 0) {
        unsigned* bar = b.bar;
        __builtin_amdgcn_s_waitcnt(0);
        unsigned nloc = b.st[0], nx = b.st[1];
        if (nloc == 0u) { xcd_barrier_complete(bar, b.x, nloc, nx); b.st[0] = nloc; b.st[1] = nx; }
        const unsigned old = xb_add(&bar[XB_XSUB(b.x)], 1u);
        const unsigned gen = old / nloc;
        if (old + 1u == (gen + 1u) * nloc) {
            __builtin_amdgcn_fence(__ATOMIC_RELEASE, "agent");
            asm volatile("s_waitcnt vmcnt(0)" ::: "memory");
            const unsigned og = xb_add(&bar[XB_TOP], 1u);
            const unsigned tg = og / nx;
            if (og + 1u == (tg + 1u) * nx) xb_add(&bar[XB_TOPGEN], 1u);
            else XB_SPIN(xb_ld(&bar[XB_TOPGEN]) == tg, bar);
            __builtin_amdgcn_fence(__ATOMIC_ACQUIRE, "agent");
            xb_add(&bar[XB_XGEN(b.x)], 1u);
            asm volatile("s_waitcnt vmcnt(0)" ::: "memory");
        } else {
            XB_SPIN(xb_ld(&bar[XB_XGEN(b.x)]) == gen, bar);
            __builtin_amdgcn_fence(__ATOMIC_ACQUIRE, "agent");
            asm volatile("s_waitcnt vmcnt(0)" ::: "memory");
        }
    }
    __syncthreads();
}


__global__ void __launch_bounds__(512, 2) hybrid_fwd(Params p) {
    extern __shared__ __attribute__((aligned(16))) unsigned char lds_raw[];
    LAS unsigned char* lds = (LAS unsigned char*)lds_raw;
    cg::grid_group grid = cg::this_grid();
    if (threadIdx.x < 16) ((LAS unsigned*)(lds + RING_BYTES))[threadIdx.x] = 0u;
    __syncthreads();
    const XcdBarrier xbar = xcd_barrier_post((unsigned*)(p.ws + WS_BAR), (volatile LAS unsigned*)(lds + RING_BYTES));
    const int tid = threadIdx.x, lane = tid & 63, wid = __builtin_amdgcn_readfirstlane(tid >> 6);
    const int G = gridDim.x, bx = blockIdx.x;
    unsigned char* ws = p.ws;
    float* cosb = (float*)(ws + WS_TAB + TB_COSB); float* sinb = (float*)(ws + WS_TAB + TB_SINB);
    float* cosd = (float*)(ws + WS_TAB + TB_COSD); float* sind = (float*)(ws + WS_TAB + TB_SIND);
    float* rs0 = (float*)(ws + WS_RS0); float* rs1 = (float*)(ws + WS_RS1); float* rsq = (float*)(ws + WS_RSQ); float* rskv = (float*)(ws + WS_RSKV);
    float* kpart = (float*)(ws + WS_KPART);
    bf16_t* xb = (bf16_t*)(ws + WS_XB);
    unsigned char* Pb = ws + WS_P; unsigned char* Ub = ws + WS_U;

    {
        LAS float* scr = (LAS float*)(lds + wid * 16384);
        const int gw = bx * 8 + wid, NGW = G * 8;
        for (int l = 0; l < NL; ++l)
            for (int j = 0; j < 35; ++j) { const TJob t = get_job(p, l, j); const int nit = (t.kdst / 64) * (t.ndst / 32);
                for (int it = gw; it < nit; it += NGW) transpose_item(t, scr, it, lane); }
        const int gt = bx * 512 + tid, NGT = G * 512;
        for (int idx = gt; idx < NL * 65536; idx += NGT) { const int l = idx >> 16, e = idx & 65535, tt = (e >> 7) & 127, s = e & 127;
            const float v = (s <= tt) ? p.a_w_s[idx] : 0.f; ((bf16_t*)(ws + WS_W + (size_t)l * W_LAYER + OW_S))[e] = (bf16_t)(cvtpk(v, 0.f) & 0xffffu); }
        for (int idx = gt; idx < SEQ * 8; idx += NGT) { const int pos = idx >> 3, i = idx & 7; const float ang = (float)pos * p.invb[i]; float s, c; sincos_d(ang, s, c); cosb[idx] = c; sinb[idx] = s; }
        for (int idx = gt; idx < SEQ * 16; idx += NGT) { const int pos = idx >> 4, i = idx & 15; const float ang = (float)pos * p.invd[i]; float s, c; sincos_d(ang, s, c); cosd[idx] = c; sind[idx] = s; }
        for (int panel = bx; panel < NPANEL; panel += G) prep_panel(p.x + (size_t)panel * 256 * DM, xb + (size_t)panel * 256 * DM, rs0 + panel * 256, wid, lane);
    }
    grid.sync();

    const int NG = G >> 3, gid0 = (G == 256) ? ((bx & 7) * 4 + (bx >> 6)) : (bx >> 3), mem = (G == 256) ? ((bx >> 3) & 7) : (bx & 7);
    const bool ingrp = (bx < NG * 8);
    unsigned char* Uw = Ub + (size_t)bx * USTRIDE;
    for (int l = 0; l < NL; ++l) {
        unsigned char* wl = ws + WS_W + (size_t)l * W_LAYER;
        if (ingrp) for (int gq = gid0; gq < 32; gq += NG) {
            pg8::Gemm g{xb, (const bf16_t*)(wl + OW_IN), 1024, 1024, 1024, (size_t)256 * 1024 * 2}; pg8::Seq S{10, mem, 8, 10, gq * 8, 1, 0, 0, 0, 1};
            EpiInProj E{Pb, rs0, cosb, sinb, cosd, sind, kpart};
            pg8::gemm_phase<EpiInProj>(lds, g, S, E);
        }
        xcd_barrier(xbar);
        if (ingrp) for (int gq = gid0; gq < 32; gq += NG) {
            const int panel = gq * 8 + mem;
            unsigned char* Pp = Pb + (size_t)panel * PSTRIDE; unsigned char* Up = Ub + (size_t)panel * USTRIDE;
            const int pos0 = (panel & 15) * 256;
            {
                const int tq = opaque_tid(); const int row = tq >> 1, hf = tq & 1;
                const bf16_t* cq = (const bf16_t*)(Pp + B_CQ * BUFB) + row * 256 + hf * 96; float s = 0.f;
#pragma unroll
                for (int k = 0; k < 12; ++k) { const bf16x8 v = *(const bf16x8*)(cq + 8 * k);
#pragma unroll
                    for (int e = 0; e < 8; ++e) { const float f = bf2f(v[e]); s += f * f; } }
                s += __shfl_xor(s, 1);
                const bf16_t* ck = (const bf16_t*)(Pp + B_CKV * BUFB) + row * 256 + hf * 64; float s2 = 0.f;
#pragma unroll
                for (int k = 0; k < 8; ++k) { const bf16x8 v = *(const bf16x8*)(ck + 8 * k);
#pragma unroll
                    for (int e = 0; e < 8; ++e) { const float f = bf2f(v[e]); s2 += f * f; } }
                s2 += __shfl_xor(s2, 1);
                if (hf == 0) { rsq[panel * 256 + row] = 1.0f / sqrtf(s * (1.f / 192.f) + EPS); rskv[panel * 256 + row] = 1.0f / sqrtf(s2 * (1.f / 128.f) + EPS); }
                __syncthreads();
            }
            {
                pg8::Gemm g{(const bf16_t*)(Pp + B_CQ * BUFB), (const bf16_t*)(wl + OW_UQ), 256, 256, 256, 0}; pg8::Seq S{2, 0, 1, 2, 0, 0, 0, 0, 0, 1};
                EpiUpQ E{(bf16_t*)(Up + U_QD), rsq + panel * 256, cosd, sind, pos0};
                pg8::gemm_phase<EpiUpQ>(lds, g, S, E);
            }
            {
                pg8::Gemm g{(const bf16_t*)(Pp + B_CKV * BUFB), (const bf16_t*)(wl + OW_UKV), 256, 128, 128, 0}; pg8::Seq S{2, 0, 1, 2, 0, 0, 0, 0, 0, 1};
                EpiUpKV E{(bf16_t*)(Up + U_KD), (bf16_t*)(Up + U_VD), rskv + panel * 256};
                pg8::gemm_phase<EpiUpKV>(lds, g, S, E);
            }
            for (int c = 0; c < 2; ++c) {
                constexpr int VS = 272;
                {
                    const int tq = opaque_tid(); const int t = tq >> 2, part = tq & 3;
                    const bf16_t* vp = (const bf16_t*)(Pp + B_AV * BUFB) + (128 * c + t) * 256 + part * 64;
                    bf16x8 vv[8]; float s = 0.f, s2 = 0.f;
#pragma unroll
                    for (int k = 0; k < 8; ++k) { vv[k] = *(const bf16x8*)(vp + 8 * k);
#pragma unroll
                        for (int e = 0; e < 8; ++e) { const float f = bf2f(vv[k][e]); s += f; s2 += f * f; } }
                    s += __shfl_xor(s, 1); s += __shfl_xor(s, 2); s2 += __shfl_xor(s2, 1); s2 += __shfl_xor(s2, 2);
                    const float mean = s * (1.f / 256.f), var = fmaxf(s2 * (1.f / 256.f) - mean * mean, 0.f), rstd = 1.0f / sqrtf(var + 1e-5f);
                    const float* lg = p.a_ln_g + l * 256 + part * 64; const float* lb = p.a_ln_b + l * 256 + part * 64;
#pragma unroll
                    for (int k = 0; k < 8; ++k)
#pragma unroll
                        for (int e = 0; e < 8; ++e) { const int ch = part * 64 + 8 * k + e; const float f = (bf2f(vv[k][e]) - mean) * rstd * lg[8 * k + e] + lb[8 * k + e];
                            *(LAS unsigned short*)(lds + ch * VS + t * 2) = (unsigned short)(cvtpk(f, 0.f) & 0xffffu); }
                }
                __syncthreads();
                {
                    const int tq = opaque_tid(); const int lq = tq & 63; const int g4 = wid & 3, th = wid >> 2, r = lq & 31, hh = lq >> 5;
                    const bf16_t* Wg = (const bf16_t*)(wl + OW_S) + (size_t)g4 * 128 * 128;
                    const float* bs = p.a_b_s + (l * 4 + g4) * 128;
                    bf16_t* au = (bf16_t*)(Pp + B_AU * BUFB);
#pragma unroll
                    for (int tb = 0; tb < 2; ++tb) {
                        const int t0 = 64 * th + 32 * tb;
                        f32x16 a0, a1;
#pragma unroll
                        for (int i = 0; i < 16; ++i) { a0[i] = 0.f; a1[i] = 0.f; }
                        for (int ks = 0; 16 * ks <= t0 + 31; ++ks) {
                            const bf16x8 wa = *(const bf16x8*)(Wg + (t0 + r) * 128 + 16 * ks + 8 * hh);
                            const bf16x8 b0 = *(const LAS bf16x8*)(lds + (64 * g4 + r) * VS + (16 * ks + 8 * hh) * 2);
                            const bf16x8 b1 = *(const LAS bf16x8*)(lds + (64 * g4 + 32 + r) * VS + (16 * ks + 8 * hh) * 2);
                            a0 = MFMA32(wa, b0, a0); a1 = MFMA32(wa, b1, a1);
                        }
#pragma unroll
                        for (int i = 0; i < 16; ++i) { const int t = t0 + crow(i, hh); const float bb = bs[t]; bf16_t* up = au + (128 * c + t) * 256 + 64 * g4 + r;
                            const float u0 = bf2f((short)up[0]), u1 = bf2f((short)up[32]);
                            up[0] = (bf16_t)(cvtpk(u0 * (a0[i] + bb), 0.f) & 0xffffu); up[32] = (bf16_t)(cvtpk(u1 * (a1[i] + bb), 0.f) & 0xffffu); }
                    }
                }
                __syncthreads();
            }
        }
        xcd_barrier(xbar);
        for (int panel = bx; panel < NPANEL; panel += G) {
            unsigned char* Pp = Pb + (size_t)panel * PSTRIDE; const int pos0 = (panel & 15) * 256;
            const float* wc = p.c_w_conv + l * 3 * 256;
            const int tqc = opaque_tid();
            for (int it = 0; it < 16; ++it) {
                const int item = it * 512 + tqc, row = item >> 5, ch = (item & 31) * 8; const int pos = pos0 + row;
                float z[3][8];
#pragma unroll
                for (int d = 0; d < 3; ++d) {
                    if (pos - d >= 0) { const int rr = row - d; const unsigned char* Pz = rr >= 0 ? Pp : Pp - PSTRIDE; const int ri = rr >= 0 ? rr : rr + 256;
                        const bf16x8 cc = *(const bf16x8*)((const bf16_t*)(Pz + B_CC * BUFB) + ri * 256 + ch), cx = *(const bf16x8*)((const bf16_t*)(Pz + B_CX * BUFB) + ri * 256 + ch);
#pragma unroll
                        for (int e = 0; e < 8; ++e) z[d][e] = bf2f(cc[e]) * bf2f(cx[e]); }
                    else {
#pragma unroll
                        for (int e = 0; e < 8; ++e) z[d][e] = 0.f; }
                }
                bf16_t* cbp = (bf16_t*)(Pp + B_CB * BUFB) + row * 256 + ch; const bf16x8 cb = *(const bf16x8*)cbp; float o[8];
#pragma unroll
                for (int e = 0; e < 8; ++e) o[e] = bf2f(cb[e]) * (wc[ch + e] * z[2][e] + wc[256 + ch + e] * z[1][e] + wc[512 + ch + e] * z[0][e]);
                u32x4 w; w.x = cvtpk(o[0], o[1]); w.y = cvtpk(o[2], o[3]); w.z = cvtpk(o[4], o[5]); w.w = cvtpk(o[6], o[7]);
                *(u32x4*)cbp = w;
            }
        }
        for (int v = bx; v < 256; v += G) {
            const int bh = v >> 2, s = v & 3, b = bh >> 2, h = bh & 3;
            for (int i = 0; i < 4; ++i) { const int qb = (i == 0) ? s : (i == 1) ? 7 - s : (i == 2) ? 8 + s : 15 - s;
                attn_unit<64, true>(b, h, qb, Pb, Ub, kpart, lds, B_BQ);
                attn_unit<96, false>(b, h, qb, Pb, Ub, kpart, lds, B_CQ); }
        }
        xcd_barrier(xbar);
        if (ingrp) for (int gq = gid0; gq < 32; gq += NG)
            for (int q = mem; q < 32; q += 8) {
                const int panel = gq * 8 + (q >> 2), pnn = q & 3;
                {
                    pg8::Gemm g{xb, (const bf16_t*)(wl + OW_G), 1024, 1024, 1024, (size_t)256 * 1024 * 2}; pg8::Seq S{4, 0, 1, 4, panel, 0, 0, pnn, 0, 4};
                    EpiG E{Uw + U_G, rs0 + panel * 256};
                    pg8::gemm_phase<EpiG>(lds, g, S, E);
                }
                {
                    pg8::Gemm g{(const bf16_t*)Pb, (const bf16_t*)(wl + OW_B), 256, 256, 256, BUFB}; pg8::Seq S{4, 0, 1, 4, panel * 10, 0, 1, pnn, 0, 4};
                    EpiY E{Uw + U_G, Uw + U_M, (bf16_t*)(Ub + (size_t)panel * USTRIDE + U_MERGED), pnn, panel * 10};
                    pg8::gemm_phase<EpiY>(lds, g, S, E);
                }
            }
        xcd_barrier(xbar);
        if (ingrp) for (int gq = gid0; gq < 32; gq += NG) {
            pg8::Gemm g{(const bf16_t*)(Ub + U_MERGED), (const bf16_t*)(wl + OW_OUT), 1024, 1024, 1024, USTRIDE}; pg8::Seq S{4, mem, 8, 4, gq * 8, 1, 0, 0, 0, 1};
            EpiF32 E{(float*)Pb, 0};
            pg8::gemm_phase<EpiF32>(lds, g, S, E);
        }
        xcd_barrier(xbar);
        for (int panel = bx; panel < NPANEL; panel += G) {
            float* xo = p.out + (size_t)panel * 256 * DM;
            norm_step((const float*)(Pb + (size_t)panel * PSTRIDE), (l == 0) ? p.x + (size_t)panel * 256 * DM : xo, xo, xb + (size_t)panel * 256 * DM, rs1 + panel * 256, p.g_post_mix + l * DM, wid, lane);
        }
        xcd_barrier(xbar);
        for (int hf = 0; hf < 2; ++hf) {
            if (ingrp) for (int gq = gid0; gq < 32; gq += NG) {
                pg8::Gemm g{xb, (const bf16_t*)(wl + OW_1), 1024, 1024, 1024, (size_t)256 * 1024 * 2}; pg8::Seq S{8, mem, 8, 8, gq * 8, 1, 0, hf * 8, 0, 1};
                EpiMlpIn E{Ub, rs1, hf * 8};
                pg8::gemm_phase<EpiMlpIn>(lds, g, S, E);
            }
            xcd_barrier(xbar);
            if (ingrp) for (int gq = gid0; gq < 32; gq += NG) {
                pg8::Gemm g{(const bf16_t*)Ub, (const bf16_t*)(wl + OW_2) + hf * 2048, 2048, 4096, 2048, USTRIDE}; pg8::Seq S{4, mem, 8, 4, gq * 8, 1, 0, 0, 0, 1};
                EpiF32 E{(float*)Pb, hf};
                pg8::gemm_phase<EpiF32>(lds, g, S, E);
            }
            xcd_barrier(xbar);
        }
        for (int panel = bx; panel < NPANEL; panel += G) {
            float* xo = p.out + (size_t)panel * 256 * DM;
            norm_step((const float*)(Pb + (size_t)panel * PSTRIDE), xo, xo, xb + (size_t)panel * 256 * DM, rs0 + panel * 256, p.g_post_mlp + l * DM, wid, lane);
        }
        xcd_barrier(xbar);
    }
}

extern "C" void kernel_launch(void* const* d_in, const int* in_sizes, int n_in, void* d_out, int out_size, void* d_ws, size_t ws_size, hipStream_t stream) {
    static int grid = 0;
    if (grid == 0) {
        if (n_in != 19 || out_size != T * DM || ws_size < WS_END) { fprintf(stderr, "kernel_launch: unexpected shapes (n_in %d out %d ws %zu need %zu)\n", n_in, out_size, ws_size, (size_t)WS_END); grid = -1; return; }
        int dev = 0, cus = 0, per_cu = 0;
        hipGetDevice(&dev); hipDeviceGetAttribute(&cus, hipDeviceAttributeMultiprocessorCount, dev);
        hipFuncSetAttribute((const void*)hybrid_fwd, hipFuncAttributeMaxDynamicSharedMemorySize, LDS_BYTES);
        hipOccupancyMaxActiveBlocksPerMultiprocessor(&per_cu, (const void*)hybrid_fwd, 512, LDS_BYTES);
        if (per_cu < 1) per_cu = 1;
        (void)hipGetLastError();
        grid = cus * per_cu; if (grid > 256) grid = 256;
    }
    if (grid < 0) return;
    Params p{};
    const float** pp = (const float**)&p;
    for (int i = 0; i < 19; ++i) pp[i] = (const float*)d_in[i];
    p.out = (float*)d_out; p.ws = (unsigned char*)d_ws;
    for (int i = 0; i < 8; ++i) p.invb[i] = 1.0f / powf(500000.0f, (float)(2 * i) / 16.0f);
    for (int i = 0; i < 16; ++i) p.invd[i] = 1.0f / powf(500000.0f, (float)(2 * i) / 32.0f);
    (void)hipMemsetAsync((char*)d_ws + WS_BAR, 0, 16384, stream);
    void* args[] = {&p};
    hipError_t e = hipLaunchCooperativeKernel((const void*)hybrid_fwd, dim3(grid), dim3(512), args, LDS_BYTES, stream);
    if (e != hipSuccess) fprintf(stderr, "cooperative launch failed: %s (grid %d)\n", hipGetErrorString(e), grid);
}
```
